# Optimizing an MI355X kernel written in HIP

```python
import jax, jax.numpy as jnp
from jax import lax
import numpy as np

D_MODEL = 2048
BATCH = 4
SEQ = 8192
DEPTH = 1

D_MIX = D_MODEL
D_GMLP = D_MIX // 2
D_ATTN = D_MIX - D_GMLP
GMLP_HEADS = 8
GMLP_HEAD_DIM = D_GMLP // GMLP_HEADS
GMLP_CHUNK = 128
ATTN_HEADS = 8
ATTN_HEAD_DIM = D_ATTN // ATTN_HEADS
DILATION_PATTERNS = ((128, 1), (512, 4), (2048, 16))
ATTN_BLOCK = 128
D_IN = 2 * D_GMLP + 3 * D_ATTN
N_GROUPS = 4
EXPERTS_PER_GROUP = 8
N_EXPERTS = N_GROUPS * EXPERTS_PER_GROUP
TOP_K = 2
D_EXPERT = D_MODEL // 2
MOE_BLOCK = 128
N_MOD = 6
EPS = 1e-6

kernel_name = "hybrid_gmlp_dilated_attn_hmoe"


def rms_norm(x, g):
    xf = x.astype(jnp.float32)
    y = xf * lax.rsqrt(jnp.mean(xf * xf, axis=-1, keepdims=True) + EPS)
    return (y * g.astype(jnp.float32)).astype(x.dtype)


def layer_norm(x, g):
    xf = x.astype(jnp.float32)
    xc = xf - jnp.mean(xf, axis=-1, keepdims=True)
    y = xc * lax.rsqrt(jnp.mean(xc * xc, axis=-1, keepdims=True) + EPS)
    return (y * g.astype(jnp.float32)).astype(x.dtype)


def gmlp_spatial_gating(u, v, w_s, b_s):
    B, S, _ = u.shape
    n_chunks = S // GMLP_CHUNK
    vc = v.reshape(B, n_chunks, GMLP_CHUNK, GMLP_HEADS, GMLP_HEAD_DIM)
    causal = jnp.tril(jnp.ones((GMLP_CHUNK, GMLP_CHUNK), dtype=bool))
    wm = jnp.where(causal[None], w_s, jnp.zeros_like(w_s)).astype(v.dtype)
    sv = jnp.einsum('hts,bcshd->bcthd', wm, vc) + b_s.T[:, :, None].astype(v.dtype)
    return u * sv.reshape(B, S, D_GMLP)


def dilated_window_attention(q, k, v, window, dilation):
    B, S, H, E = q.shape
    band = window // dilation
    L = S // dilation
    nb = -(-L // ATTN_BLOCK)
    Lp = nb * ATTN_BLOCK
    blk = ATTN_BLOCK

    def to_blocks(t):
        t = t.reshape(B, L, dilation, H, E)
        t = jnp.pad(t, ((0, 0), (0, Lp - L), (0, 0), (0, 0), (0, 0)))
        return t.reshape(B, nb, blk, dilation, H, E)

    qb, kb, vb = to_blocks(q), to_blocks(k), to_blocks(v)

    def with_prev(t):
        prev = jnp.concatenate([jnp.zeros_like(t[:, :1]), t[:, :-1]], axis=1)
        return jnp.concatenate([prev, t], axis=2)

    kk, vv = with_prev(kb), with_prev(vb)
    s = jnp.einsum('bnqrhe,bnkrhe->bnrhqk', qb, kk,
                   preferred_element_type=jnp.float32) * (E ** -0.5)
    qi = jnp.arange(blk)[:, None]
    kj = jnp.arange(2 * blk)[None, :]
    dist = blk + qi - kj
    in_band = (dist >= 0) & (dist <= band)
    has_prev = (jnp.arange(nb)[:, None, None] > 0) | (kj[None] >= blk)
    mask = (in_band[None] & has_prev)[None, :, None, None]
    s = jnp.where(mask, s, -jnp.inf)
    m = jnp.max(s, axis=-1, keepdims=True)
    p = jnp.exp(s - m)
    l = jnp.sum(p, axis=-1)
    o = jnp.einsum('bnrhqk,bnkrhe->bnqrhe', p, vv.astype(jnp.float32))
    l_t = jnp.transpose(l, (0, 1, 4, 2, 3))
    lse_t = jnp.transpose(m[..., 0], (0, 1, 4, 2, 3)) + jnp.log(l_t)
    o = o / l_t[..., None]
    o = o.reshape(B, Lp, dilation, H, E)[:, :L].reshape(B, S, H, E)
    lse = lse_t.reshape(B, Lp, dilation, H)[:, :L].reshape(B, S, H)
    return o, lse


def dilated_mixture_attention(q, k, v):
    outs, lses = [], []
    for window, dilation in DILATION_PATTERNS:
        o, lse = dilated_window_attention(q, k, v, window, dilation)
        outs.append(o)
        lses.append(lse)
    w = jax.nn.softmax(jnp.stack(lses, axis=0), axis=0)
    o = jnp.sum(w[..., None] * jnp.stack(outs, axis=0), axis=0)
    return o.astype(q.dtype)


def hierarchical_moe(h, w_rg, b_rg, w_re, b_re, w_gate, w_up, w_down):
    B, S, D = h.shape
    N = B * S
    hf = h.reshape(N, D)
    pg = jax.nn.softmax((hf @ w_rg + b_rg).astype(jnp.float32), axis=-1)
    gp, gi = lax.top_k(pg, 1)
    le = (jnp.einsum('nd,gde->nge', hf, w_re) + b_re).astype(jnp.float32)
    le = jnp.take_along_axis(le, gi[:, :, None], axis=1)[:, 0]
    pe = jax.nn.softmax(le, axis=-1)
    ep, ei = lax.top_k(pe, TOP_K)
    ep = ep / jnp.sum(ep, axis=-1, keepdims=True)
    weights = gp * ep
    expert_id = gi * EXPERTS_PER_GROUP + ei

    A = N * TOP_K
    e_flat = expert_id.reshape(A).astype(jnp.int32)
    tok = jnp.repeat(jnp.arange(N, dtype=jnp.int32), TOP_K)
    wt = weights.reshape(A)
    order = jnp.argsort(e_flat)
    sorted_e = e_flat[order]
    counts = jnp.bincount(e_flat, length=N_EXPERTS).astype(jnp.int32)
    padded = ((counts + MOE_BLOCK - 1) // MOE_BLOCK) * MOE_BLOCK
    pend = jnp.cumsum(padded)
    pstart = pend - padded
    cstart = jnp.cumsum(counts) - counts
    rank = jnp.arange(A, dtype=jnp.int32) - cstart[sorted_e]
    dest = pstart[sorted_e] + rank
    n_blocks = (A + N_EXPERTS * (MOE_BLOCK - 1) + MOE_BLOCK - 1) // MOE_BLOCK
    P = n_blocks * MOE_BLOCK
    row_tok = jnp.zeros((P,), jnp.int32).at[dest].set(tok[order])
    row_w = jnp.zeros((P,), jnp.float32).at[dest].set(wt[order])
    block_starts = jnp.arange(n_blocks, dtype=jnp.int32) * MOE_BLOCK
    block_e = jnp.minimum(jnp.searchsorted(pend, block_starts, side='right'),
                          N_EXPERTS - 1).astype(jnp.int32)
    xs = hf[row_tok].reshape(n_blocks, MOE_BLOCK, D)

    def expert_block(args):
        xb, e = args
        return (jax.nn.silu(xb @ w_gate[e]) * (xb @ w_up[e])) @ w_down[e]

    ys = lax.map(expert_block, (xs, block_e)).reshape(P, D)
    ys = ys * row_w[:, None].astype(ys.dtype)
    out = jax.ops.segment_sum(ys, row_tok, num_segments=N)
    return out.reshape(B, S, D).astype(h.dtype)


def setup_inputs(seed: int = 0) -> dict:
    key = jax.random.key(seed)
    ks = jax.random.split(key, 24)
    f32 = jnp.float32
    n = lambda k, shape, s: (jax.random.normal(k, shape, f32) * s)
    gain = lambda k, shape: 1.0 + 0.05 * jax.random.normal(k, shape, f32)
    L = DEPTH
    return {
        "x": n(ks[0], (BATCH, SEQ, D_MODEL), 1.0),
        "c": n(ks[1], (BATCH, D_MODEL), 1.0),
        "w_mod": n(ks[2], (L, D_MODEL, N_MOD * D_MODEL), 0.2 * D_MODEL ** -0.5),
        "b_mod": n(ks[3], (L, N_MOD * D_MODEL), 0.01),
        "g_pre_mix": gain(ks[4], (L, D_MODEL)),
        "g_post_mix": gain(ks[5], (L, D_MODEL)),
        "w_in": n(ks[6], (L, D_MODEL, D_IN), D_MODEL ** -0.5),
        "g_gmlp_v": gain(ks[7], (L, D_GMLP)),
        "w_spatial": n(ks[8], (L, GMLP_HEADS, GMLP_CHUNK, GMLP_CHUNK), 0.5 * GMLP_CHUNK ** -0.5),
        "b_spatial": gain(ks[9], (L, GMLP_HEADS, GMLP_CHUNK)),
        "g_out_gmlp": gain(ks[10], (L, D_GMLP)),
        "g_out_attn": gain(ks[11], (L, D_ATTN)),
        "w_out": n(ks[12], (L, D_MIX, D_MODEL), D_MIX ** -0.5),
        "g_pre_ffn": gain(ks[13], (L, D_MODEL)),
        "g_post_ffn": gain(ks[14], (L, D_MODEL)),
        "w_router_group": n(ks[15], (L, D_MODEL, N_GROUPS), D_MODEL ** -0.5),
        "b_router_group": n(ks[16], (L, N_GROUPS), 0.01),
        "w_router_expert": n(ks[17], (L, N_GROUPS, D_MODEL, EXPERTS_PER_GROUP), D_MODEL ** -0.5),
        "b_router_expert": n(ks[18], (L, N_GROUPS, EXPERTS_PER_GROUP), 0.01),
        "w_gate": n(ks[19], (L, N_EXPERTS, D_MODEL, D_EXPERT), D_MODEL ** -0.5),
        "w_up": n(ks[20], (L, N_EXPERTS, D_MODEL, D_EXPERT), D_MODEL ** -0.5),
        "w_down": n(ks[21], (L, N_EXPERTS, D_EXPERT, D_MODEL), D_EXPERT ** -0.5),
    }


def reference(x, c, w_mod, b_mod, g_pre_mix, g_post_mix, w_in, g_gmlp_v, w_spatial,
              b_spatial, g_out_gmlp, g_out_attn, w_out, g_pre_ffn, g_post_ffn,
              w_router_group, b_router_group, w_router_expert, b_router_expert,
              w_gate, w_up, w_down):
    B, S, D = x.shape
    for l in range(DEPTH):
        mod = jax.nn.silu(c) @ w_mod[l] + b_mod[l]
        shift1, scale1, gate1, shift2, scale2, gate2 = [
            t[:, None, :] for t in jnp.split(mod, N_MOD, axis=-1)]

        h = rms_norm(x, g_pre_mix[l]) * (1 + scale1) + shift1
        proj = h @ w_in[l]
        u, v, q, k, va = jnp.split(
            proj, [D_GMLP, 2 * D_GMLP, 2 * D_GMLP + D_ATTN, 2 * D_GMLP + 2 * D_ATTN], axis=-1)
        u = jax.nn.gelu(u)
        v = layer_norm(jax.nn.gelu(v), g_gmlp_v[l])
        ya = gmlp_spatial_gating(u, v, w_spatial[l], b_spatial[l])
        hs = (B, S, ATTN_HEADS, ATTN_HEAD_DIM)
        yb = dilated_mixture_attention(q.reshape(hs), k.reshape(hs), va.reshape(hs))
        yb = yb.reshape(B, S, D_ATTN)
        y = jnp.concatenate([rms_norm(ya, g_out_gmlp[l]), rms_norm(yb, g_out_attn[l])], axis=-1)
        y = y @ w_out[l]
        x = x + gate1 * rms_norm(y, g_post_mix[l])

        h = rms_norm(x, g_pre_ffn[l]) * (1 + scale2) + shift2
        y = hierarchical_moe(h, w_router_group[l], b_router_group[l], w_router_expert[l],
                             b_router_expert[l], w_gate[l], w_up[l], w_down[l])
        x = x + gate2 * rms_norm(y, g_post_ffn[l])
    return x
```

```cpp
#include <hip/hip_runtime.h>
#include <cstdio>
#include <cstdint>

#ifndef MK_N_LAUNCHES
#define MK_N_LAUNCHES 1
#endif

#define LAS __attribute__((address_space(3)))
#define GAS __attribute__((address_space(1)))
typedef unsigned short bf16;
typedef short bf16x8 __attribute__((ext_vector_type(8)));
typedef short s16x4 __attribute__((ext_vector_type(4)));
typedef float f32x4 __attribute__((ext_vector_type(4)));
typedef float f32x2 __attribute__((ext_vector_type(2)));
typedef float f32x16 __attribute__((ext_vector_type(16)));
typedef unsigned u32x4 __attribute__((ext_vector_type(4)));
typedef unsigned u32x2 __attribute__((ext_vector_type(2)));
typedef __bf16 bf16x2_t __attribute__((ext_vector_type(2)));
typedef short v4i16_t __attribute__((ext_vector_type(4)));

constexpr int NB = 4, SEQ = 8192, NTOK = NB * SEQ, DM = 2048, DIN = 5120, DG = 1024, NE = 32, DE = 1024;
constexpr int NMOD = 6 * DM;
constexpr float EPS = 1e-6f;
constexpr int PMAX = 73728;
constexpr int TMAX = PMAX / 256;
constexpr float QSCALE = 0.12751743f;

__device__ __forceinline__ unsigned cvtpk(float lo, float hi) { f32x2 v = {lo, hi}; bf16x2_t b = __builtin_convertvector(v, bf16x2_t); return __builtin_bit_cast(unsigned, b); }
__device__ __forceinline__ float bflo(unsigned w) { return __uint_as_float(w << 16); }
__device__ __forceinline__ float bfhi(unsigned w) { return __uint_as_float(w & 0xffff0000u); }
__device__ __forceinline__ float wave_sum(float v) {
#pragma unroll
    for (int o = 1; o < 64; o <<= 1) v += __shfl_xor(v, o);
    return v;
}
__device__ __forceinline__ float gelu_t(float v) { const float u = v * (1.0f + 0.044715f * v * v); const float e = __builtin_amdgcn_exp2f(-2.302208198f * u); return v * __builtin_amdgcn_rcpf(1.0f + e); }
__device__ __forceinline__ float silu_f(float v) { return v * __builtin_amdgcn_rcpf(1.0f + __builtin_amdgcn_exp2f(-1.442695041f * v)); }

namespace pg8 {
constexpr int BM = 256, BK = 64, HALF = 128, HTB = HALF * BK * 2, STAGE_BYTES = 8 * HTB, NXCD = 8, WGM = 8;
__host__ __device__ __forceinline__ int lds_byte(int r, int c) { const int st = (r >> 4) * 2 + (c >> 5), rr = r & 15, cc = c & 31, ob = rr * 64 + cc * 2; return st * 1024 + (ob ^ (((ob >> 9) & 1) << 5)); }
__host__ __device__ __forceinline__ void stage_rc(int b, int& R, int& C) { const int st = b / 1024, sb = b % 1024, swz = sb ^ (((sb >> 9) & 1) << 5); R = (st >> 1) * 16 + swz / 64; C = (st & 1) * 32 + (swz % 64) / 2; }
__host__ __device__ __forceinline__ int perm32(int rho) { const int n = rho >> 4, i = rho & 15; return 8 * (i >> 2) + 4 * n + (i & 3); }

struct Unit { int pm, pn; };
struct Gemm { const bf16* A; const bf16* Bt; int K; int lda; const int* arow; };

struct StaticOrder {
    int nM, nN, nwg, G, c;
    __device__ void init(int nM_, int nN_, int G_, int c_) { nM = nM_; nN = nN_; nwg = nM * nN; G = G_; c = c_; }
    __device__ bool next(int i, Unit& u) const {
        const long L = (long)i * G + c; if (L >= nwg) return false;
        int wgid = (int)L; { const int q = nwg / NXCD, r = nwg % NXCD, xcd = wgid % NXCD, off = wgid / NXCD; wgid = (xcd < r ? xcd * (q + 1) : r * (q + 1) + (xcd - r) * q) + off; }
        const int nig = WGM * nN, gid = wgid / nig, fm = gid * WGM, gsz = (nM - fm) < WGM ? (nM - fm) : WGM;
        u.pm = fm + ((wgid % nig) % gsz); u.pn = (wgid % nig) / gsz; return true;
    }
    __device__ __forceinline__ int bidx(const Unit& u) const { return u.pn; }
};
struct MoeOrder : StaticOrder {
    const LAS int* tile_e;
    __device__ __forceinline__ int bidx(const Unit& u) const { return tile_e[u.pm] * nN + u.pn; }
};

struct EpiInProj {
    static constexpr bool PERM = true;
    bf16* O; int ldc;
    __device__ __forceinline__ void operator()(const f32x4 (&acc)[2][2][4][2], const Unit& u, int wr, int wc, int fr, int fq) const {
        const int row0 = u.pm * BM + wr * 64 + fr, col0 = u.pn * BM + wc * 32 + 8 * fq;
        const int mode = u.pn < 8 ? 0 : (u.pn < 12 ? 1 : 2);
#pragma unroll
        for (int ai = 0; ai < 2; ++ai)
#pragma unroll
            for (int m = 0; m < 4; ++m) { bf16* rowp = O + (size_t)(row0 + ai * HALF + m * 16) * ldc + col0;
#pragma unroll
                for (int bj = 0; bj < 2; ++bj) { f32x4 v0 = acc[ai][bj][m][0], v1 = acc[ai][bj][m][1];
                    if (mode == 0) {
#pragma unroll
                        for (int j = 0; j < 4; ++j) { v0[j] = gelu_t(v0[j]); v1[j] = gelu_t(v1[j]); } }
                    else if (mode == 1) { v0 = v0 * QSCALE; v1 = v1 * QSCALE; }
                    u32x4 w; w.x = cvtpk(v0[0], v0[1]); w.y = cvtpk(v0[2], v0[3]); w.z = cvtpk(v1[0], v1[1]); w.w = cvtpk(v1[2], v1[3]);
                    *(u32x4*)(rowp + bj * HALF) = w; } }
    }
};
struct EpiPlain {
    static constexpr bool PERM = true;
    bf16* O; int ldc;
    __device__ __forceinline__ void operator()(const f32x4 (&acc)[2][2][4][2], const Unit& u, int wr, int wc, int fr, int fq) const {
        const int row0 = u.pm * BM + wr * 64 + fr, col0 = u.pn * BM + wc * 32 + 8 * fq;
#pragma unroll
        for (int ai = 0; ai < 2; ++ai)
#pragma unroll
            for (int m = 0; m < 4; ++m) { bf16* rowp = O + (size_t)(row0 + ai * HALF + m * 16) * ldc + col0;
#pragma unroll
                for (int bj = 0; bj < 2; ++bj) { const f32x4 v0 = acc[ai][bj][m][0], v1 = acc[ai][bj][m][1];
                    u32x4 w; w.x = cvtpk(v0[0], v0[1]); w.y = cvtpk(v0[2], v0[3]); w.z = cvtpk(v1[0], v1[1]); w.w = cvtpk(v1[2], v1[3]);
                    *(u32x4*)(rowp + bj * HALF) = w; } }
    }
};
struct EpiSwiglu {
    static constexpr bool PERM = true;
    bf16* O; int ldc;
    __device__ __forceinline__ void operator()(const f32x4 (&acc)[2][2][4][2], const Unit& u, int wr, int wc, int fr, int fq) const {
        const int row0 = u.pm * BM + wr * 64 + fr, col0 = u.pn * HALF + wc * 32 + 8 * fq;
#pragma unroll
        for (int ai = 0; ai < 2; ++ai)
#pragma unroll
            for (int m = 0; m < 4; ++m) { bf16* rowp = O + (size_t)(row0 + ai * HALF + m * 16) * ldc + col0;
                f32x4 v0, v1;
#pragma unroll
                for (int j = 0; j < 4; ++j) { v0[j] = silu_f(acc[ai][0][m][0][j]) * acc[ai][1][m][0][j]; v1[j] = silu_f(acc[ai][0][m][1][j]) * acc[ai][1][m][1][j]; }
                u32x4 w; w.x = cvtpk(v0[0], v0[1]); w.y = cvtpk(v0[2], v0[3]); w.z = cvtpk(v1[0], v1[1]); w.w = cvtpk(v1[2], v1[3]);
                *(u32x4*)rowp = w; }
    }
};

template <class Epi, class Sched, bool ALIGN_EPI, bool GATHER>
__device__ __forceinline__ void gemm_phase(LAS unsigned char* lds, const Gemm g, const Sched& S, const Epi& E) {
    const int tid = threadIdx.x, wid = __builtin_amdgcn_readfirstlane(tid >> 6), lane = tid & 63, wr = wid >> 2, wc = wid & 3, fr = lane & 15, fq = lane >> 4;
    const int K = g.K, nt = K / BK, lda = g.lda;
    unsigned voffB[2]; int RA[2], CA[2];
    unsigned oc[2][2], on[2][2];
#pragma unroll
    for (int i = 0; i < 2; ++i) { int R, C; stage_rc(tid * 16 + i * 8192, R, C); const int Rb = Epi::PERM ? ((R & ~31) + perm32(R & 31)) : R;
        RA[i] = R; CA[i] = C; voffB[i] = (unsigned)(Rb * K + C) * 2u; }
    const size_t kstep = (size_t)(BK * 2);
    const size_t hstepB = (size_t)HALF * K * 2, tstepB = 2 * hstepB;
    const size_t tstepA = (size_t)BM * lda * 2;
    const unsigned ldsw = (unsigned)wid * 1024u;
    const int aoff = lds_byte(wr * 64 + fr, fq * 8), boff = lds_byte(wc * 32 + fr, fq * 8);
#define PG8_SA(b, h) (((b) * 2 + (h)) * HTB)
#define PG8_SB(b, h) ((4 + (b) * 2 + (h)) * HTB)
#define PG8_STAGE(bufoff, gbase, voff) do { _Pragma("unroll") for (int _i = 0; _i < 2; ++_i) \
        __builtin_amdgcn_global_load_lds((const unsigned*)((const char*)(gbase) + (voff)[_i]), (LAS unsigned*)(lds + (bufoff) + ldsw + _i * 8192), 16, 0, 0); } while (0)
#define PG8_LDA(dst, b, h) do { _Pragma("unroll") for (int m = 0; m < 4; ++m) _Pragma("unroll") for (int k = 0; k < 2; ++k) dst[m][k] = *(const LAS bf16x8*)(lds + PG8_SA(b, h) + aoff + m * 2048 + k * 1024); } while (0)
#define PG8_LDB(dst, b, h) do { _Pragma("unroll") for (int n = 0; n < 2; ++n) _Pragma("unroll") for (int k = 0; k < 2; ++k) dst[n][k] = *(const LAS bf16x8*)(lds + PG8_SB(b, h) + boff + n * 2048 + k * 1024); } while (0)
#define PG8_MMA(ai, bj, At, Bt) do { __builtin_amdgcn_s_setprio(1); _Pragma("unroll") for (int m = 0; m < 4; ++m) _Pragma("unroll") for (int n = 0; n < 2; ++n) _Pragma("unroll") for (int k = 0; k < 2; ++k) \
        acc[ai][bj][m][n] = __builtin_amdgcn_mfma_f32_16x16x32_bf16(Bt[n][k], At[m][k], acc[ai][bj][m][n], 0, 0, 0); __builtin_amdgcn_s_setprio(0); } while (0)
#define PG8_WAIT_V(n) asm volatile("s_waitcnt vmcnt(" #n ")" ::: "memory")
#define PG8_WAIT_L(n) asm volatile("s_waitcnt lgkmcnt(" #n ")" ::: "memory")
#define PG8_BAR __builtin_amdgcn_s_barrier()
#define PG8_SCHED __builtin_amdgcn_sched_barrier(0)
#define PG8_AOFF(dst, pm_) do { _Pragma("unroll") for (int _h = 0; _h < 2; ++_h) _Pragma("unroll") for (int _i = 0; _i < 2; ++_i) { \
        if constexpr (GATHER) dst[_h][_i] = ((unsigned)g.arow[(pm_) * BM + _h * HALF + RA[_i]] * (unsigned)lda + (unsigned)CA[_i]) * 2u; \
        else dst[_h][_i] = ((unsigned)(_h * HALF + RA[_i]) * (unsigned)lda + (unsigned)CA[_i]) * 2u; } } while (0)
    Unit cur, nxt; int ui = 0;
    if (!S.next(0, cur)) return;
    f32x4 acc[2][2][4][2];
#pragma unroll
    for (int a = 0; a < 2; ++a)
#pragma unroll
        for (int b = 0; b < 2; ++b)
#pragma unroll
            for (int m = 0; m < 4; ++m)
#pragma unroll
                for (int n = 0; n < 2; ++n) acc[a][b][m][n] = (f32x4){0.f, 0.f, 0.f, 0.f};
    bf16x8 At[4][2], B0[2][2], B1[2][2];
    PG8_AOFF(oc, cur.pm);
    const char* cA = (const char*)g.A + (GATHER ? (size_t)0 : (size_t)cur.pm * tstepA); const char* cB = (const char*)g.Bt + (size_t)S.bidx(cur) * tstepB;
    PG8_STAGE(PG8_SB(0, 0), cB, voffB); PG8_STAGE(PG8_SB(0, 1), cB + hstepB, voffB); PG8_STAGE(PG8_SA(0, 0), cA, oc[0]); PG8_STAGE(PG8_SA(0, 1), cA, oc[1]);
    if (wr == 1) PG8_BAR;
    PG8_WAIT_V(2); PG8_BAR;
    PG8_STAGE(PG8_SB(1, 0), cB + kstep, voffB); PG8_STAGE(PG8_SA(1, 0), cA + kstep, oc[0]); PG8_STAGE(PG8_SB(1, 1), cB + hstepB + kstep, voffB);
    PG8_WAIT_V(6); PG8_BAR;
    for (;;) {
        const bool has_next = S.next(ui + 1, nxt);
        const char* nA = cA; const char* nB = cB;
        if (has_next) { nA = (const char*)g.A + (GATHER ? (size_t)0 : (size_t)nxt.pm * tstepA); nB = (const char*)g.Bt + (size_t)S.bidx(nxt) * tstepB; PG8_AOFF(on, nxt.pm); }
        else {
#pragma unroll
            for (int h = 0; h < 2; ++h)
#pragma unroll
                for (int i = 0; i < 2; ++i) on[h][i] = oc[h][i]; }
        for (int t = 0; t < nt; t += 2) {
            const bool last = (t == nt - 2);
            const char* a1 = cA + (size_t)(t + 1) * kstep;
            const char* a2 = last ? nA : cA + (size_t)(t + 2) * kstep; const char* b2 = last ? nB : cB + (size_t)(t + 2) * kstep;
            const char* a3 = a2 + kstep; const char* b3 = b2 + kstep;
            unsigned o2[2][2];
#pragma unroll
            for (int h = 0; h < 2; ++h)
#pragma unroll
                for (int i = 0; i < 2; ++i) o2[h][i] = last ? on[h][i] : oc[h][i];
            PG8_LDB(B0, 0, 0); PG8_LDB(B1, 0, 1); PG8_SCHED; PG8_LDA(At, 0, 0); PG8_STAGE(PG8_SA(1, 1), a1, oc[1]);
            PG8_WAIT_V(8); PG8_WAIT_L(0); PG8_BAR; PG8_MMA(0, 0, At, B0); PG8_MMA(0, 1, At, B1); PG8_BAR; PG8_SCHED;
            PG8_LDA(At, 0, 1); PG8_STAGE(PG8_SB(0, 0), b2, voffB); PG8_STAGE(PG8_SB(0, 1), b2 + hstepB, voffB); PG8_STAGE(PG8_SA(0, 0), a2, o2[0]);
            PG8_WAIT_V(8); PG8_WAIT_L(0); PG8_BAR; PG8_MMA(1, 0, At, B0); PG8_MMA(1, 1, At, B1); PG8_BAR; PG8_SCHED;
            PG8_LDB(B0, 1, 0); PG8_LDB(B1, 1, 1); PG8_SCHED; PG8_LDA(At, 1, 0); PG8_STAGE(PG8_SA(0, 1), a2, o2[1]);
            PG8_WAIT_V(8); PG8_WAIT_L(0); PG8_BAR; PG8_MMA(0, 0, At, B0); PG8_MMA(0, 1, At, B1); PG8_BAR; PG8_SCHED;
            PG8_LDA(At, 1, 1); PG8_STAGE(PG8_SB(1, 0), b3, voffB); PG8_STAGE(PG8_SB(1, 1), b3 + hstepB, voffB); PG8_STAGE(PG8_SA(1, 0), a3, o2[0]);
            PG8_WAIT_V(8); PG8_WAIT_L(0); PG8_BAR; PG8_MMA(1, 0, At, B0); PG8_MMA(1, 1, At, B1); PG8_BAR; PG8_SCHED;
        }
        if constexpr (ALIGN_EPI) { if (wr == 0) PG8_BAR; }
        E(acc, cur, wr, wc, fr, fq);
        if (!has_next) break;
#pragma unroll
        for (int a = 0; a < 2; ++a)
#pragma unroll
            for (int b = 0; b < 2; ++b)
#pragma unroll
                for (int m = 0; m < 4; ++m)
#pragma unroll
                    for (int n = 0; n < 2; ++n) acc[a][b][m][n] = (f32x4){0.f, 0.f, 0.f, 0.f};
        cur = nxt; cA = nA; cB = nB; ++ui;
#pragma unroll
        for (int h = 0; h < 2; ++h)
#pragma unroll
            for (int i = 0; i < 2; ++i) oc[h][i] = on[h][i];
        if constexpr (ALIGN_EPI) { if (wr == 1) PG8_BAR; }
    }
    PG8_WAIT_V(0);
    if constexpr (!ALIGN_EPI) { if (wr == 0) PG8_BAR; }
    PG8_BAR;
#undef PG8_SA
#undef PG8_SB
#undef PG8_STAGE
#undef PG8_LDA
#undef PG8_LDB
#undef PG8_MMA
#undef PG8_WAIT_V
#undef PG8_WAIT_L
#undef PG8_BAR
#undef PG8_SCHED
#undef PG8_AOFF
}
}

constexpr size_t MiB = 1u << 20;
constexpr size_t WS_CTL = 0, CTL_ZERO_BYTES = 1 * MiB;
constexpr size_t WS_ROWTOK = 65536;
constexpr size_t WS_MOD = 1 * MiB;
constexpr size_t WS_WSM = 1 * MiB + 256 * 1024;
constexpr size_t WS_YASS = 1 * MiB + 512 * 1024;
constexpr size_t WS_EID = 1 * MiB + 768 * 1024;
constexpr size_t WS_LRANK = 2 * MiB;
constexpr size_t WS_WT = 2 * MiB + 256 * 1024;
constexpr size_t WS_TOKPOS = 2 * MiB + 512 * 1024;
constexpr size_t WS_LCNT = 2 * MiB + 768 * 1024;
constexpr size_t WS_ML = 3 * MiB;
constexpr size_t WS_WIN = 10 * MiB;
constexpr size_t WS_WOUT = 30 * MiB;
constexpr size_t WS_WGU = 38 * MiB;
constexpr size_t WS_WDN = 294 * MiB;
constexpr size_t WS_HB = 422 * MiB;
constexpr size_t WS_PROJ = 550 * MiB;
constexpr size_t WS_OPART = 870 * MiB;
constexpr size_t WS_Y1 = 870 * MiB;
constexpr size_t WS_ACT = 550 * MiB;
constexpr size_t WS_YBUF = 694 * MiB;
constexpr size_t WS_END = 1062 * MiB;
static_assert(WS_ROWTOK + (size_t)PMAX * 4 <= CTL_ZERO_BYTES, "ROWTOK inside the memset region");
static_assert(WS_ACT + (size_t)PMAX * DE * 2 <= WS_YBUF && WS_YBUF + (size_t)PMAX * DM * 2 <= WS_END && WS_OPART + (size_t)3 * NTOK * 1024 * 2 <= WS_END, "d_ws map");
constexpr int CW_BAR = 4096;

constexpr int RING_BYTES = 139264;
constexpr int MISC_OFF = RING_BYTES;
constexpr int LDS_BYTES = 147456;
constexpr int NWAVES = 8;
constexpr int NPHASE = 11;

#define RLX_AGENT __ATOMIC_RELAXED, __HIP_MEMORY_SCOPE_AGENT
#define XB_TMO      128
#define XB_XCNT(j)  (256  + 64 * (j))
#define XB_XSUB(j)  (1280 + 64 * (j))
#define XB_XGEN(j)  (2304 + 64 * (j))
#define XB_TOP      3328
#define XB_TOPGEN   3392
#define XCD_BAR_WORDS 3456
#define XB_SPIN_CAP (1u << 18)
__device__ __forceinline__ unsigned xb_ld(unsigned* p)              { return __hip_atomic_load(p, __ATOMIC_RELAXED, __HIP_MEMORY_SCOPE_AGENT); }
__device__ __forceinline__ unsigned xb_add(unsigned* p, unsigned v) { return __hip_atomic_fetch_add(p, v, __ATOMIC_RELAXED, __HIP_MEMORY_SCOPE_AGENT); }
__device__ __forceinline__ unsigned xb_xcc_id() { return (unsigned)__builtin_amdgcn_s_getreg((3 << 11) | 20) & 0xFu; }
#define XB_SPIN(cond, bar) do { unsigned _sp = 0; while (cond) { __builtin_amdgcn_s_sleep(1); \
    if ((++_sp & 255u) == 0u) { if (xb_ld(&(bar)[XB_TMO])) break; if (_sp > XB_SPIN_CAP) { atomicAdd(&(bar)[XB_TMO], 1u); break; } } } } while (0)
struct XcdBarrier { unsigned* bar; unsigned x; volatile LAS unsigned* st; };
__device__ __forceinline__ XcdBarrier xcd_barrier_post(unsigned* bar, volatile LAS unsigned* st) {
    XcdBarrier b; b.bar = bar; b.x = xb_xcc_id(); b.st = st;
    if (threadIdx.x == 0) (void)xb_add(&bar[XB_XCNT(b.x)], 1u);
    return b;
}
__device__ __forceinline__ void xcd_barrier_complete(unsigned* bar, unsigned x, unsigned& nloc, unsigned& nx) {
    const unsigned G = gridDim.x * gridDim.y * gridDim.z;
    unsigned sum, cnt, mine, sp = 0u;
    for (;;) {
        sum = 0u; cnt = 0u; mine = 0u;
#pragma unroll
        for (unsigned j = 0; j < 16; ++j) { const unsigned c = xb_ld(&bar[XB_XCNT(j)]); sum += c; cnt += (c > 0u) ? 1u : 0u; mine = (j == x) ? c : mine; }
        if (sum == G) break;
        __builtin_amdgcn_s_sleep(1);
        if ((++sp & 255u) == 0u) { if (xb_ld(&bar[XB_TMO])) break; if (sp > XB_SPIN_CAP) { atomicAdd(&bar[XB_TMO], 1u); break; } }
    }
    nloc = mine > 0u ? mine : 1u; nx = cnt > 0u ? cnt : 1u;
}
__device__ __forceinline__ void xcd_barrier(const XcdBarrier& b) {
    asm volatile("s_waitcnt vmcnt(0)" ::: "memory");
    __syncthreads();
    if (threadIdx.x == 0) {
        unsigned* bar = b.bar;
        __builtin_amdgcn_s_waitcnt(0);
        unsigned nloc = b.st[0], nx = b.st[1];
        if (nloc == 0u) { xcd_barrier_complete(bar, b.x, nloc, nx); b.st[0] = nloc; b.st[1] = nx; }
        const unsigned old = xb_add(&bar[XB_XSUB(b.x)], 1u);
        const unsigned gen = old / nloc;
        if (old + 1u == (gen + 1u) * nloc) {
            __builtin_amdgcn_fence(__ATOMIC_RELEASE, "agent");
            asm volatile("s_waitcnt vmcnt(0)" ::: "memory");
            const unsigned og = xb_add(&bar[XB_TOP], 1u);
            const unsigned tg = og / nx;
            if (og + 1u == (tg + 1u) * nx) xb_add(&bar[XB_TOPGEN], 1u);
            else XB_SPIN(xb_ld(&bar[XB_TOPGEN]) == tg, bar);
            __builtin_amdgcn_fence(__ATOMIC_ACQUIRE, "agent");
            xb_add(&bar[XB_XGEN(b.x)], 1u);
            asm volatile("s_waitcnt vmcnt(0)" ::: "memory");
        } else {
            XB_SPIN(xb_ld(&bar[XB_XGEN(b.x)]) == gen, bar);
            __builtin_amdgcn_fence(__ATOMIC_ACQUIRE, "agent");
            asm volatile("s_waitcnt vmcnt(0)" ::: "memory");
        }
    }
    __syncthreads();
}

__device__ __forceinline__ s16x4 vtr(const LAS unsigned char* p) { return __builtin_bit_cast(s16x4, __builtin_amdgcn_ds_read_tr16_b64_v4i16((LAS v4i16_t*)p)); }
#define MFMA32(a, b, c) __builtin_amdgcn_mfma_f32_32x32x16_bf16((a), (b), (c), 0, 0, 0)
__device__ __forceinline__ int crow(int r, int hi) { return (r & 3) + 8 * (r >> 2) + 4 * hi; }
__device__ __forceinline__ void unpack8(const u32x4 w, float (&f)[8]) { f[0] = bflo(w.x); f[1] = bfhi(w.x); f[2] = bflo(w.y); f[3] = bfhi(w.y); f[4] = bflo(w.z); f[5] = bfhi(w.z); f[6] = bflo(w.w); f[7] = bfhi(w.w); }
__device__ __forceinline__ u32x4 pack8(const float (&f)[8]) { u32x4 w; w.x = cvtpk(f[0], f[1]); w.y = cvtpk(f[2], f[3]); w.z = cvtpk(f[4], f[5]); w.w = cvtpk(f[6], f[7]); return w; }

struct Args { const float* in[22]; float* out; unsigned char* ws; int ph_lo, ph_hi; };

__device__ __forceinline__ void transpose_item(const float* W, int N, int k0, int n0, bf16* dst, int ldk, LAS float* scr, int lane) {
    const int cl = lane & 15, kq = lane >> 4;
#pragma unroll 4
    for (int i = 0; i < 16; ++i) { const int kk = 4 * i + kq; const f32x4 v = *(const f32x4*)(W + (size_t)(k0 + kk) * N + n0 + 4 * cl);
        LAS float* s = scr + kk * 65 + 4 * cl; s[0] = v[0]; s[1] = v[1]; s[2] = v[2]; s[3] = v[3]; }
    asm volatile("s_waitcnt lgkmcnt(0)" ::: "memory");
    const int c = lane >> 3, nn = lane & 7;
#pragma unroll
    for (int it = 0; it < 8; ++it) { const int n = nn + 8 * it; const LAS float* s = scr + (8 * c) * 65 + n;
        u32x4 o; o.x = cvtpk(s[0], s[65]); o.y = cvtpk(s[2 * 65], s[3 * 65]); o.z = cvtpk(s[4 * 65], s[5 * 65]); o.w = cvtpk(s[6 * 65], s[7 * 65]);
        *(u32x4*)(dst + (size_t)n * ldk + k0 + 8 * c) = o; }
    asm volatile("s_waitcnt lgkmcnt(0)" ::: "memory");
}

__device__ __forceinline__ void build_tiles(const int* lcnt, int G, int c, LAS unsigned char* lds, bool want_base) {
    LAS int* tot = (LAS int*)(lds + MISC_OFF + 4096); LAS int* wof = tot + 32;
    LAS int* ttab = (LAS int*)(lds + MISC_OFF + 256); LAS int* base = (LAS int*)(lds + MISC_OFF + 2048);
    const int tid = threadIdx.x;
    if (tid < 32) { int t = 0, b = 0; for (int w = 0; w < G; ++w) { const int v = lcnt[w * 32 + tid]; t += v; if (w < c) b += v; } tot[tid] = t; wof[tid] = b; }
    __syncthreads();
    if (tid == 0) { int ts = 0; for (int e = 0; e < 32; ++e) { const int nt = (tot[e] + 255) >> 8; for (int j = 0; j < nt; ++j) ttab[1 + ts + j] = e; if (want_base) base[e] = ts * 256 + wof[e]; ts += nt; } ttab[0] = ts; }
    __syncthreads();
}

__global__ void __launch_bounds__(NWAVES * 64, 2) fwd_kernel(Args args) {
    extern __shared__ __attribute__((aligned(16))) unsigned char lds_raw[];
    LAS unsigned char* lds = (LAS unsigned char*)lds_raw;
    const int tid = threadIdx.x, lane = tid & 63, wave = __builtin_amdgcn_readfirstlane(tid >> 6);
    const int G = gridDim.x, c = blockIdx.x;
    const int gw = c * NWAVES + wave, NGW = G * NWAVES;
    unsigned char* ws = args.ws;
    unsigned* ctl = (unsigned*)(ws + WS_CTL);
    const float* x = args.in[0]; const float* cvec = args.in[1]; const float* w_mod = args.in[2]; const float* b_mod = args.in[3];
    const float* g_pre_mix = args.in[4]; const float* g_post_mix = args.in[5]; const float* w_in = args.in[6]; const float* g_gmlp_v = args.in[7];
    const float* w_spatial = args.in[8]; const float* b_spatial = args.in[9]; const float* g_out_gmlp = args.in[10]; const float* g_out_attn = args.in[11];
    const float* w_out = args.in[12]; const float* g_pre_ffn = args.in[13]; const float* g_post_ffn = args.in[14];
    const float* w_rg = args.in[15]; const float* b_rg = args.in[16]; const float* w_re = args.in[17]; const float* b_re = args.in[18];
    const float* w_gate = args.in[19]; const float* w_up = args.in[20]; const float* w_down = args.in[21];
    float* out = args.out;
    int* ROWTOK = (int*)(ws + WS_ROWTOK); float* MOD = (float*)(ws + WS_MOD); bf16* WSM = (bf16*)(ws + WS_WSM); float* YASS = (float*)(ws + WS_YASS);
    int* EID = (int*)(ws + WS_EID); int* LRANK = (int*)(ws + WS_LRANK); float* WT = (float*)(ws + WS_WT); int* TOKPOS = (int*)(ws + WS_TOKPOS); int* LCNT = (int*)(ws + WS_LCNT);
    float* ML = (float*)(ws + WS_ML);
    bf16* WIN = (bf16*)(ws + WS_WIN); bf16* WOUT = (bf16*)(ws + WS_WOUT); bf16* WGU = (bf16*)(ws + WS_WGU); bf16* WDN = (bf16*)(ws + WS_WDN);
    bf16* HB = (bf16*)(ws + WS_HB); bf16* PROJ = (bf16*)(ws + WS_PROJ); bf16* OPART = (bf16*)(ws + WS_OPART); bf16* Y1 = (bf16*)(ws + WS_Y1);
    bf16* ACT = (bf16*)(ws + WS_ACT); bf16* YBUF = (bf16*)(ws + WS_YBUF);

    for (int u = tid; u < (LDS_BYTES - MISC_OFF) / 4; u += NWAVES * 64) ((LAS unsigned*)(lds + MISC_OFF))[u] = 0u;
    __syncthreads();
    XcdBarrier bar; bar.bar = ctl + CW_BAR; bar.x = 0; bar.st = nullptr;
    if (MK_N_LAUNCHES == 1) bar = xcd_barrier_post(ctl + CW_BAR, (volatile LAS unsigned*)(lds + MISC_OFF));
    const int lo = args.ph_lo, hi = args.ph_hi;
#define IN(k) (lo <= (k) && (k) < hi)
#define SEAM(k) do { if (MK_N_LAUNCHES == 1 && IN(k) && IN((k) + 1)) xcd_barrier(bar); } while (0)

    if (IN(0)) {
        {
            LAS float* sc = (LAS float*)lds; LAS float* red = (LAS float*)(lds + 32768);
            const int kg = tid >> 4, cl = tid & 15;
            for (int u = c; u < NMOD / 64; u += G) {
                const int n0 = u * 64;
                for (int i = tid; i < NB * DM; i += 512) sc[i] = silu_f(cvec[i]);
                __syncthreads();
                float acc[4][4];
#pragma unroll
                for (int b = 0; b < 4; ++b)
#pragma unroll
                    for (int j = 0; j < 4; ++j) acc[b][j] = 0.f;
#pragma unroll 4
                for (int k = kg; k < DM; k += 32) { const f32x4 w = *(const f32x4*)(w_mod + (size_t)k * NMOD + n0 + 4 * cl);
#pragma unroll
                    for (int b = 0; b < 4; ++b) { const float s = sc[b * DM + k];
#pragma unroll
                        for (int j = 0; j < 4; ++j) acc[b][j] += s * w[j]; } }
#pragma unroll
                for (int b = 0; b < 4; ++b)
#pragma unroll
                    for (int j = 0; j < 4; ++j) red[(kg * 4 + b) * 64 + 4 * cl + j] = acc[b][j];
                __syncthreads();
                if (tid < 256) { const int b = tid >> 6, n = tid & 63; float s = 0.f; for (int q = 0; q < 32; ++q) s += red[(q * 4 + b) * 64 + n]; MOD[b * NMOD + n0 + n] = s + b_mod[n0 + n]; }
                __syncthreads();
            }
        }
        {
            LAS float* scr = (LAS float*)(lds + wave * 16640);
            constexpr int I_IN = 32 * 80, I_OUT = 32 * 32, I_G = 32 * 16 * 32, I_D = 16 * 32 * 32;
            constexpr int NITEMS = I_IN + I_OUT + 2 * I_G + I_D;
            for (int it = gw; it < NITEMS; it += NGW) {
                int r = it;
                if (r < I_IN) { const int kb = r / 80, nb = r % 80; transpose_item(w_in, DIN, kb * 64, nb * 64, WIN + (size_t)(nb * 64) * DM, DM, scr, lane); continue; } r -= I_IN;
                if (r < I_OUT) { const int kb = r / 32, nb = r % 32; transpose_item(w_out, DM, kb * 64, nb * 64, WOUT + (size_t)(nb * 64) * DM, DM, scr, lane); continue; } r -= I_OUT;
                if (r < 2 * I_G) { const int up = r >= I_G; if (up) r -= I_G; const int e = r / 512, q = r % 512, kb = q / 16, nb = q % 16, n0 = nb * 64;
                    const float* W = (up ? w_up : w_gate) + (size_t)e * DM * DE;
                    const size_t row0 = (size_t)(e * 8 + (n0 >> 7)) * 256 + (n0 & 127) + (up ? 128 : 0);
                    transpose_item(W, DE, kb * 64, n0, WGU + row0 * DM, DM, scr, lane); continue; } r -= 2 * I_G;
                { const int e = r / 512, q = r % 512, kb = q / 32, nb = q % 32; const float* W = w_down + (size_t)e * DE * DM;
                  transpose_item(W, DM, kb * 64, nb * 64, WDN + ((size_t)e * DM + nb * 64) * DE, DE, scr, lane); }
            }
        }
        for (int i = c * 512 + tid; i < 8 * 128 * 128; i += G * 512) { const int s = i & 127, t = (i >> 7) & 127; const float v = s <= t ? w_spatial[i] : 0.f; WSM[i] = (bf16)(cvtpk(v, 0.f) & 0xffffu); }
    }
    SEAM(0);

    if (IN(1)) {
        const int RPW = NTOK / NGW, row0 = gw * RPW, b = row0 / SEQ;
        float av[32], sv[32];
#pragma unroll
        for (int j = 0; j < 4; ++j)
#pragma unroll
            for (int i = 0; i < 8; ++i) { const int ch = 512 * j + 8 * lane + i; av[8 * j + i] = g_pre_mix[ch] * (1.0f + MOD[b * NMOD + 1 * DM + ch]); sv[8 * j + i] = MOD[b * NMOD + 0 * DM + ch]; }
        for (int r = 0; r < RPW; ++r) {
            const float* xr = x + (size_t)(row0 + r) * DM; float xv[32]; float ss = 0.f;
#pragma unroll
            for (int j = 0; j < 4; ++j) { const f32x4 a = *(const f32x4*)(xr + 512 * j + 8 * lane), bq = *(const f32x4*)(xr + 512 * j + 8 * lane + 4);
#pragma unroll
                for (int i = 0; i < 4; ++i) { xv[8 * j + i] = a[i]; xv[8 * j + 4 + i] = bq[i]; ss += a[i] * a[i] + bq[i] * bq[i]; } }
            const float rstd = __builtin_amdgcn_rsqf(wave_sum(ss) * (1.0f / DM) + EPS);
            bf16* hr = HB + (size_t)(row0 + r) * DM;
#pragma unroll
            for (int j = 0; j < 4; ++j) { float f[8];
#pragma unroll
                for (int i = 0; i < 8; ++i) f[i] = xv[8 * j + i] * rstd * av[8 * j + i] + sv[8 * j + i];
                *(u32x4*)(hr + 512 * j + 8 * lane) = pack8(f); }
        }
    }
    SEAM(1);

    if (IN(2)) {
        pg8::Gemm g{HB, WIN, DM, DM, nullptr}; pg8::StaticOrder S; S.init(NTOK / 256, DIN / 256, G, c);
        pg8::EpiInProj E{PROJ, DIN};
        pg8::gemm_phase<pg8::EpiInProj, pg8::StaticOrder, true, false>(lds, g, S, E);
    }
    SEAM(2);

    if (IN(3)) {
        {
            LAS unsigned char* VT = lds; LAS f32x2* stats = (LAS f32x2*)(lds + 81920); LAS float* ssqL = (LAS float*)(lds + 83968);
            const int r32 = lane & 31, hh2 = lane >> 5, blk = (lane >> 4) & 1, q4 = (lane & 15) >> 2, p4 = lane & 3;
            const int tb = wave & 3, dh = wave >> 2;
            for (int u = c; u < NTOK / 128; u += G) {
                const int t0 = u * 128;
                for (int rr = 0; rr < 16; ++rr) {
                    const int row = 16 * wave + rr; const bf16* p = PROJ + (size_t)(t0 + row) * DIN + DG + 16 * lane;
                    const u32x4 a = *(const u32x4*)p, bq = *(const u32x4*)(p + 8); float f[8], g2[8]; unpack8(a, f); unpack8(bq, g2);
                    float s = 0.f, s2 = 0.f;
#pragma unroll
                    for (int i = 0; i < 8; ++i) { s += f[i] + g2[i]; s2 += f[i] * f[i] + g2[i] * g2[i]; }
                    s = wave_sum(s); s2 = wave_sum(s2);
                    const float mean = s * (1.0f / DG), var = s2 * (1.0f / DG) - mean * mean;
                    if (lane == 0) stats[row] = (f32x2){mean, __builtin_amdgcn_rsqf(fmaxf(var, 0.f) + EPS)};
                }
                __syncthreads();
                float ssq = 0.f;
#define P3_STAGE(hh, buf) do { _Pragma("unroll") for (int q = 0; q < 4; ++q) { const int idx = tid + 512 * q, s = idx >> 4, ch = idx & 15; \
                    const u32x4 raw = *(const u32x4*)(PROJ + (size_t)(t0 + s) * DIN + DG + (hh) * 128 + 8 * ch); float f[8]; unpack8(raw, f); \
                    const f32x2 st = stats[s]; const f32x4 ga = *(const f32x4*)(g_gmlp_v + (hh) * 128 + 8 * ch), gb = *(const f32x4*)(g_gmlp_v + (hh) * 128 + 8 * ch + 4); \
                    _Pragma("unroll") for (int i = 0; i < 4; ++i) { f[i] = (f[i] - st.x) * st.y * ga[i]; f[4 + i] = (f[4 + i] - st.x) * st.y * gb[i]; } \
                    *(LAS u32x4*)(VT + (buf) * 40960 + s * 320 + ch * 16) = pack8(f); } } while (0)
                P3_STAGE(0, 0);
                __syncthreads();
                for (int hh = 0; hh < 8; ++hh) {
                    const int buf = hh & 1;
                    if (hh + 1 < 8) P3_STAGE(hh + 1, buf ^ 1);
                    f32x16 acc0 = {}, acc1 = {};
                    const int nks = 2 * (tb + 1);
                    const bf16* wrow = WSM + ((size_t)(hh * 128 + 32 * tb + r32)) * 128 + 8 * hh2;
                    const LAS unsigned char* vb = VT + buf * 40960 + (8 * hh2 + q4) * 320 + (64 * dh + 16 * blk + 4 * p4) * 2;
                    for (int ks = 0; ks < nks; ++ks) {
                        const bf16x8 bw = *(const bf16x8*)(wrow + 16 * ks);
                        const LAS unsigned char* vk = vb + ks * 16 * 320;
                        const s16x4 l0 = vtr(vk), h0 = vtr(vk + 4 * 320), l1 = vtr(vk + 64), h1 = vtr(vk + 4 * 320 + 64);
                        const bf16x8 a0 = {l0[0], l0[1], l0[2], l0[3], h0[0], h0[1], h0[2], h0[3]}, a1 = {l1[0], l1[1], l1[2], l1[3], h1[0], h1[1], h1[2], h1[3]};
                        acc0 = MFMA32(a0, bw, acc0); acc1 = MFMA32(a1, bw, acc1);
                    }
                    const int tok = t0 + 32 * tb + r32; const float bsp = b_spatial[hh * 128 + 32 * tb + r32];
                    bf16* urow = PROJ + (size_t)tok * DIN + hh * 128 + 64 * dh + 4 * hh2;
#pragma unroll
                    for (int db = 0; db < 2; ++db)
#pragma unroll
                        for (int gq = 0; gq < 4; ++gq) { bf16* p = urow + 32 * db + 8 * gq; const u32x2 uu = *(const u32x2*)p;
                            const f32x16& A = db ? acc1 : acc0;
                            const float y0 = bflo(uu.x) * (A[4 * gq + 0] + bsp), y1 = bfhi(uu.x) * (A[4 * gq + 1] + bsp), y2 = bflo(uu.y) * (A[4 * gq + 2] + bsp), y3 = bfhi(uu.y) * (A[4 * gq + 3] + bsp);
                            u32x2 o; o.x = cvtpk(y0, y1); o.y = cvtpk(y2, y3);
                            const float r0 = bflo(o.x), r1 = bfhi(o.x), r2 = bflo(o.y), r3 = bfhi(o.y); ssq += r0 * r0 + r1 * r1 + r2 * r2 + r3 * r3;
                            *(u32x2*)p = o; }
                    __syncthreads();
                }
#undef P3_STAGE
                ssq += __shfl_xor(ssq, 32);
                if (lane < 32) ssqL[wave * 32 + lane] = ssq;
                __syncthreads();
                if (tid < 128) YASS[t0 + tid] = ssqL[(tid >> 5) * 32 + (tid & 31)] + ssqL[((tid >> 5) + 4) * 32 + (tid & 31)];
                __syncthreads();
            }
        }
        {
            LAS unsigned char* VT = lds;
            const int r32 = lane & 31, hh2 = lane >> 5, blk = (lane >> 4) & 1, q4 = (lane & 15) >> 2, p4 = lane & 3;
            for (int uid = c; uid < 3072; uid += G) {
                const int pat = uid >> 10, rem = uid & 1023, bh = rem >> 5, xq = rem & 31;
                const int dl = pat == 0 ? 1 : (pat == 1 ? 4 : 16), nblk = 32 / dl, res = xq / nblk, qb = xq % nblk;
                const int b = bh >> 3, head = bh & 7;
                const size_t tbase = (size_t)b * SEQ + res;
                const bf16* Pq = PROJ + 2048 + head * 128, * Pk = PROJ + 3072 + head * 128, * Pv = PROJ + 4096 + head * 128;
                {
                    u32x4 tmp[12];
#pragma unroll
                    for (int q = 0; q < 12; ++q) { const int idx = tid + 512 * q, i = idx >> 4, ch = idx & 15; int mk = 256 * qb - 128 + i; mk = mk < 0 ? 0 : mk;
                        tmp[q] = *(const u32x4*)(Pv + (tbase + (size_t)mk * dl) * DIN + 8 * ch); }
#pragma unroll
                    for (int q = 0; q < 12; ++q) { const int idx = tid + 512 * q, i = idx >> 4, ch = idx & 15; *(LAS u32x4*)(VT + i * 320 + ch * 16) = tmp[q]; }
                }
                const int mq = 256 * qb + 32 * wave + r32;
                const bf16* qrow = Pq + (tbase + (size_t)mq * dl) * DIN + 8 * hh2;
                bf16x8 qf[8];
#pragma unroll
                for (int d0 = 0; d0 < 8; ++d0) qf[d0] = *(const bf16x8*)(qrow + 16 * d0);
                const int mk0 = 256 * qb + 32 * wave - 128;
                f32x16 S[5];
#pragma unroll
                for (int kb = 0; kb < 5; ++kb) {
                    int mk = mk0 + 32 * kb + r32; mk = mk < 0 ? 0 : mk;
                    const bf16* krow = Pk + (tbase + (size_t)mk * dl) * DIN + 8 * hh2;
                    bf16x8 kf[8];
#pragma unroll
                    for (int d0 = 0; d0 < 8; ++d0) kf[d0] = *(const bf16x8*)(krow + 16 * d0);
                    f32x16 a = {};
#pragma unroll
                    for (int d0 = 0; d0 < 8; ++d0) a = MFMA32(kf[d0], qf[d0], a);
                    S[kb] = a;
                }
                float mx = -INFINITY;
#pragma unroll
                for (int kb = 0; kb < 5; ++kb)
#pragma unroll
                    for (int r = 0; r < 16; ++r) { const int kr = 32 * kb + crow(r, hh2); const int dist = 128 + r32 - kr; const bool ok = (dist >= 0) && (dist <= 128) && (mk0 + kr >= 0);
                        const float s = ok ? S[kb][r] : -INFINITY; S[kb][r] = s; mx = fmaxf(mx, s); }
                mx = fmaxf(mx, __shfl_xor(mx, 32));
                float lsum = 0.f;
#pragma unroll
                for (int kb = 0; kb < 5; ++kb)
#pragma unroll
                    for (int r = 0; r < 16; ++r) { const float p = __builtin_amdgcn_exp2f(S[kb][r] - mx); S[kb][r] = p; lsum += p; }
                lsum += __shfl_xor(lsum, 32);
                bf16x8 pf[5][2];
#pragma unroll
                for (int kb = 0; kb < 5; ++kb)
#pragma unroll
                    for (int s2 = 0; s2 < 2; ++s2) { u32x4 w; w.x = cvtpk(S[kb][8 * s2 + 0], S[kb][8 * s2 + 1]); w.y = cvtpk(S[kb][8 * s2 + 2], S[kb][8 * s2 + 3]); w.z = cvtpk(S[kb][8 * s2 + 4], S[kb][8 * s2 + 5]); w.w = cvtpk(S[kb][8 * s2 + 6], S[kb][8 * s2 + 7]);
                        pf[kb][s2] = __builtin_bit_cast(bf16x8, w); }
                __syncthreads();
                f32x16 O[4];
#pragma unroll
                for (int db = 0; db < 4; ++db) O[db] = (f32x16){};
                const LAS unsigned char* vb = VT + (32 * wave + 4 * hh2 + q4) * 320 + (16 * blk + 4 * p4) * 2;
#pragma unroll
                for (int kb = 0; kb < 5; ++kb)
#pragma unroll
                    for (int s2 = 0; s2 < 2; ++s2) { const LAS unsigned char* vk = vb + (32 * kb + 16 * s2) * 320;
#pragma unroll
                        for (int db = 0; db < 4; ++db) { const s16x4 l0 = vtr(vk + 64 * db), h0 = vtr(vk + 8 * 320 + 64 * db);
                            const bf16x8 a = {l0[0], l0[1], l0[2], l0[3], h0[0], h0[1], h0[2], h0[3]};
                            O[db] = MFMA32(a, pf[kb][s2], O[db]); } }
                const size_t tq = tbase + (size_t)mq * dl;
                bf16* orow = OPART + ((size_t)pat * NTOK + tq) * DG + head * 128 + 4 * hh2;
#pragma unroll
                for (int db = 0; db < 4; ++db)
#pragma unroll
                    for (int gq = 0; gq < 4; ++gq) { u32x2 o; o.x = cvtpk(O[db][4 * gq + 0], O[db][4 * gq + 1]); o.y = cvtpk(O[db][4 * gq + 2], O[db][4 * gq + 3]); *(u32x2*)(orow + 32 * db + 8 * gq) = o; }
                if (hh2 == 0) *(f32x2*)(ML + (((size_t)pat * NTOK + tq) * 8 + head) * 2) = (f32x2){mx, lsum};
                __syncthreads();
            }
        }
    }
    SEAM(3);

    if (IN(4)) {
        const int RPW = NTOK / NGW, row0 = gw * RPW, head = lane >> 3;
        float ga[16], gb[16];
#pragma unroll
        for (int i = 0; i < 16; ++i) { ga[i] = g_out_gmlp[16 * lane + i]; gb[i] = g_out_attn[16 * lane + i]; }
        for (int r = 0; r < RPW; ++r) {
            const size_t row = (size_t)(row0 + r);
            f32x2 ml[3]; float M = -INFINITY;
#pragma unroll
            for (int p = 0; p < 3; ++p) { ml[p] = *(const f32x2*)(ML + (((size_t)p * NTOK + row) * 8 + head) * 2); M = fmaxf(M, ml[p].x); }
            float o[16]; float den = 0.f;
#pragma unroll
            for (int i = 0; i < 16; ++i) o[i] = 0.f;
#pragma unroll
            for (int p = 0; p < 3; ++p) { const float w = __builtin_amdgcn_exp2f(ml[p].x - M); den += w * ml[p].y;
                const bf16* op = OPART + ((size_t)p * NTOK + row) * DG + 16 * lane; float f[8], f2[8]; unpack8(*(const u32x4*)op, f); unpack8(*(const u32x4*)(op + 8), f2);
#pragma unroll
                for (int i = 0; i < 8; ++i) { o[i] += w * f[i]; o[8 + i] += w * f2[i]; } }
            const float inv = 1.0f / den; float ss = 0.f;
#pragma unroll
            for (int i = 0; i < 16; ++i) { o[i] *= inv; ss += o[i] * o[i]; }
            const float rb = __builtin_amdgcn_rsqf(wave_sum(ss) * (1.0f / DG) + EPS);
            bf16* pr = PROJ + row * DIN + 16 * lane;
            { float f[8], f2[8];
#pragma unroll
              for (int i = 0; i < 8; ++i) { f[i] = o[i] * rb * gb[i]; f2[i] = o[8 + i] * rb * gb[8 + i]; }
              *(u32x4*)(pr + DG) = pack8(f); *(u32x4*)(pr + DG + 8) = pack8(f2); }
            { const float ra = __builtin_amdgcn_rsqf(YASS[row] * (1.0f / DG) + EPS); float f[8], f2[8]; unpack8(*(const u32x4*)pr, f); unpack8(*(const u32x4*)(pr + 8), f2);
#pragma unroll
              for (int i = 0; i < 8; ++i) { f[i] = f[i] * ra * ga[i]; f2[i] = f2[i] * ra * ga[8 + i]; }
              *(u32x4*)pr = pack8(f); *(u32x4*)(pr + 8) = pack8(f2); }
        }
    }
    SEAM(4);

    if (IN(5)) {
        pg8::Gemm g{PROJ, WOUT, DM, DIN, nullptr}; pg8::StaticOrder S; S.init(NTOK / 256, DM / 256, G, c);
        pg8::EpiPlain E{Y1, DM};
        pg8::gemm_phase<pg8::EpiPlain, pg8::StaticOrder, true, false>(lds, g, S, E);
    }
    SEAM(5);

    if (IN(6)) {
        const int TPW = NTOK / G, tok0 = c * TPW, b = tok0 / SEQ, RW = TPW / NWAVES;
        LAS float* A1 = (LAS float*)lds; LAS float* A2 = A1 + DM; LAS float* S2 = A2 + DM; LAS int* hist = (LAS int*)(lds + MISC_OFF + 64);
        for (int i = tid; i < DM; i += 512) { A1[i] = MOD[b * NMOD + 2 * DM + i] * g_post_mix[i]; A2[i] = g_pre_ffn[i] * (1.0f + MOD[b * NMOD + 4 * DM + i]); S2[i] = MOD[b * NMOD + 3 * DM + i]; }
        if (tid < 32) hist[tid] = 0;
        __syncthreads();
        for (int r = 0; r < RW; ++r) {
            const int tok = tok0 + wave * RW + r;
            const float* xr = x + (size_t)tok * DM; const bf16* yr = Y1 + (size_t)tok * DM; float* o1 = out + (size_t)tok * DM; bf16* hr = HB + (size_t)tok * DM;
            float xv[32], yv[32]; float ss = 0.f;
#pragma unroll
            for (int j = 0; j < 4; ++j) { float f[8]; unpack8(*(const u32x4*)(yr + 512 * j + 8 * lane), f);
#pragma unroll
                for (int i = 0; i < 8; ++i) { yv[8 * j + i] = f[i]; ss += f[i] * f[i]; } }
#pragma unroll
            for (int j = 0; j < 4; ++j) { const f32x4 a = *(const f32x4*)(xr + 512 * j + 8 * lane), bq = *(const f32x4*)(xr + 512 * j + 8 * lane + 4);
#pragma unroll
                for (int i = 0; i < 4; ++i) { xv[8 * j + i] = a[i]; xv[8 * j + 4 + i] = bq[i]; } }
            const float r1 = __builtin_amdgcn_rsqf(wave_sum(ss) * (1.0f / DM) + EPS);
            float ss2 = 0.f;
#pragma unroll
            for (int j = 0; j < 4; ++j) { const f32x4 a0 = *(const LAS f32x4*)(A1 + 512 * j + 8 * lane), a1 = *(const LAS f32x4*)(A1 + 512 * j + 8 * lane + 4);
#pragma unroll
                for (int i = 0; i < 4; ++i) { xv[8 * j + i] += a0[i] * yv[8 * j + i] * r1; xv[8 * j + 4 + i] += a1[i] * yv[8 * j + 4 + i] * r1; }
                f32x4 oa, ob;
#pragma unroll
                for (int i = 0; i < 4; ++i) { oa[i] = xv[8 * j + i]; ob[i] = xv[8 * j + 4 + i]; ss2 += oa[i] * oa[i] + ob[i] * ob[i]; }
                *(f32x4*)(o1 + 512 * j + 8 * lane) = oa; *(f32x4*)(o1 + 512 * j + 8 * lane + 4) = ob; }
            const float r2 = __builtin_amdgcn_rsqf(wave_sum(ss2) * (1.0f / DM) + EPS);
            float lg[4] = {0.f, 0.f, 0.f, 0.f};
#pragma unroll
            for (int j = 0; j < 4; ++j) { const f32x4 a0 = *(const LAS f32x4*)(A2 + 512 * j + 8 * lane), a1 = *(const LAS f32x4*)(A2 + 512 * j + 8 * lane + 4);
                const f32x4 s0 = *(const LAS f32x4*)(S2 + 512 * j + 8 * lane), s1 = *(const LAS f32x4*)(S2 + 512 * j + 8 * lane + 4);
#pragma unroll
                for (int i = 0; i < 4; ++i) { xv[8 * j + i] = xv[8 * j + i] * r2 * a0[i] + s0[i]; xv[8 * j + 4 + i] = xv[8 * j + 4 + i] * r2 * a1[i] + s1[i]; }
                float f[8];
#pragma unroll
                for (int i = 0; i < 8; ++i) f[i] = xv[8 * j + i];
                *(u32x4*)(hr + 512 * j + 8 * lane) = pack8(f);
#pragma unroll
                for (int i = 0; i < 8; ++i) { const f32x4 w = *(const f32x4*)(w_rg + (size_t)(512 * j + 8 * lane + i) * 4);
                    lg[0] += f[i] * w[0]; lg[1] += f[i] * w[1]; lg[2] += f[i] * w[2]; lg[3] += f[i] * w[3]; } }
#pragma unroll
            for (int q = 0; q < 4; ++q) lg[q] = wave_sum(lg[q]) + b_rg[q];
            int gi = 0; float gm = lg[0];
#pragma unroll
            for (int q = 1; q < 4; ++q) if (lg[q] > gm) { gm = lg[q]; gi = q; }
            gi = __builtin_amdgcn_readfirstlane(gi);
            float gden = 0.f;
#pragma unroll
            for (int q = 0; q < 4; ++q) gden += __expf(lg[q] - gm);
            const float gp = 1.0f / gden;
            float le[8];
#pragma unroll
            for (int q = 0; q < 8; ++q) le[q] = 0.f;
            const float* wre = w_re + (size_t)gi * DM * 8;
#pragma unroll
            for (int j = 0; j < 4; ++j)
#pragma unroll
                for (int i = 0; i < 8; ++i) { const float hv = xv[8 * j + i]; const float* wp = wre + (size_t)(512 * j + 8 * lane + i) * 8; const f32x4 w0 = *(const f32x4*)wp, w1 = *(const f32x4*)(wp + 4);
                    le[0] += hv * w0[0]; le[1] += hv * w0[1]; le[2] += hv * w0[2]; le[3] += hv * w0[3]; le[4] += hv * w1[0]; le[5] += hv * w1[1]; le[6] += hv * w1[2]; le[7] += hv * w1[3]; }
#pragma unroll
            for (int q = 0; q < 8; ++q) le[q] = wave_sum(le[q]) + b_re[gi * 8 + q];
            int i0 = 0; float m0 = le[0];
#pragma unroll
            for (int q = 1; q < 8; ++q) if (le[q] > m0) { m0 = le[q]; i0 = q; }
            int i1 = -1; float m1 = -INFINITY;
#pragma unroll
            for (int q = 0; q < 8; ++q) if (q != i0 && le[q] > m1) { m1 = le[q]; i1 = q; }
            const float e1 = __expf(m1 - m0), w0 = gp / (1.0f + e1), w1 = gp * e1 / (1.0f + e1);
            if (lane == 0) { const int ea = gi * 8 + i0, eb = gi * 8 + i1;
                const int ra = __hip_atomic_fetch_add(hist + ea, 1, __ATOMIC_RELAXED, __HIP_MEMORY_SCOPE_WORKGROUP), rb = __hip_atomic_fetch_add(hist + eb, 1, __ATOMIC_RELAXED, __HIP_MEMORY_SCOPE_WORKGROUP);
                EID[2 * tok] = ea; EID[2 * tok + 1] = eb; LRANK[2 * tok] = ra; LRANK[2 * tok + 1] = rb; WT[2 * tok] = w0; WT[2 * tok + 1] = w1; }
        }
        __syncthreads();
        if (tid < 32) LCNT[c * 32 + tid] = hist[tid];
    }
    SEAM(6);

    if (IN(7)) {
        build_tiles(LCNT, G, c, lds, true);
        const LAS int* base = (const LAS int*)(lds + MISC_OFF + 2048);
        const int TPW = NTOK / G, tok0 = c * TPW;
        for (int i = tid; i < 2 * TPW; i += 512) { const int idx = 2 * tok0 + i; const int e = EID[idx]; const int pos = base[e] + LRANK[idx]; ROWTOK[pos] = idx >> 1; TOKPOS[idx] = pos; }
    }
    SEAM(7);

    if (IN(8)) {
        build_tiles(LCNT, G, c, lds, false);
        const LAS int* ttab = (const LAS int*)(lds + MISC_OFF + 256);
        pg8::Gemm g{HB, WGU, DM, DM, ROWTOK}; pg8::MoeOrder S; S.init(ttab[0], 8, G, c); S.tile_e = ttab + 1;
        pg8::EpiSwiglu E{ACT, DE};
        pg8::gemm_phase<pg8::EpiSwiglu, pg8::MoeOrder, true, true>(lds, g, S, E);
    }
    SEAM(8);

    if (IN(9)) {
        build_tiles(LCNT, G, c, lds, false);
        const LAS int* ttab = (const LAS int*)(lds + MISC_OFF + 256);
        pg8::Gemm g{ACT, WDN, DE, DE, nullptr}; pg8::MoeOrder S; S.init(ttab[0], 8, G, c); S.tile_e = ttab + 1;
        pg8::EpiPlain E{YBUF, DM};
        pg8::gemm_phase<pg8::EpiPlain, pg8::MoeOrder, true, false>(lds, g, S, E);
    }
    SEAM(9);

    if (IN(10)) {
        const int RPW = NTOK / NGW, row0 = gw * RPW, b = row0 / SEQ;
        float av[32];
#pragma unroll
        for (int j = 0; j < 4; ++j)
#pragma unroll
            for (int i = 0; i < 8; ++i) { const int ch = 512 * j + 8 * lane + i; av[8 * j + i] = g_post_ffn[ch] * MOD[b * NMOD + 5 * DM + ch]; }
        for (int r = 0; r < RPW; ++r) {
            const int tok = row0 + r; const int p0 = TOKPOS[2 * tok], p1 = TOKPOS[2 * tok + 1]; const float w0 = WT[2 * tok], w1 = WT[2 * tok + 1];
            const bf16* ya = YBUF + (size_t)p0 * DM; const bf16* yb = YBUF + (size_t)p1 * DM; float* o1 = out + (size_t)tok * DM;
            float yv[32]; float ss = 0.f;
#pragma unroll
            for (int j = 0; j < 4; ++j) { float f[8], f2[8]; unpack8(*(const u32x4*)(ya + 512 * j + 8 * lane), f); unpack8(*(const u32x4*)(yb + 512 * j + 8 * lane), f2);
#pragma unroll
                for (int i = 0; i < 8; ++i) { const float v = w0 * f[i] + w1 * f2[i]; yv[8 * j + i] = v; ss += v * v; } }
            const float rs = __builtin_amdgcn_rsqf(wave_sum(ss) * (1.0f / DM) + EPS);
#pragma unroll
            for (int j = 0; j < 4; ++j) { f32x4 a = *(const f32x4*)(o1 + 512 * j + 8 * lane), bq = *(const f32x4*)(o1 + 512 * j + 8 * lane + 4);
#pragma unroll
                for (int i = 0; i < 4; ++i) { a[i] += av[8 * j + i] * yv[8 * j + i] * rs; bq[i] += av[8 * j + 4 + i] * yv[8 * j + 4 + i] * rs; }
                *(f32x4*)(o1 + 512 * j + 8 * lane) = a; *(f32x4*)(o1 + 512 * j + 8 * lane + 4) = bq; }
        }
    }
#undef IN
#undef SEAM
}

extern "C" void kernel_launch(void* const* d_in, const int* in_sizes, int n_in, void* d_out, int out_size, void* d_ws, size_t ws_size, hipStream_t stream) {
    static int grid = 0;
    if (grid == 0) {
        if (n_in != 22 || in_sizes[0] != NTOK * DM || out_size != NTOK * DM || ws_size < WS_END) { fprintf(stderr, "kernel_launch: unexpected shapes (n_in %d, in0 %d, out %d, ws %zu < %zu?)\n", n_in, n_in > 0 ? in_sizes[0] : -1, out_size, ws_size, (size_t)WS_END); grid = -1; return; }
        int dev = 0, cus = 0, per_cu = 0;
        if (hipGetDevice(&dev) != hipSuccess || hipDeviceGetAttribute(&cus, hipDeviceAttributeMultiprocessorCount, dev) != hipSuccess) { grid = -1; return; }
        if (hipFuncSetAttribute((const void*)fwd_kernel, hipFuncAttributeMaxDynamicSharedMemorySize, LDS_BYTES) != hipSuccess) { fprintf(stderr, "kernel_launch: hipFuncSetAttribute failed\n"); grid = -1; return; }
        if (hipOccupancyMaxActiveBlocksPerMultiprocessor(&per_cu, (const void*)fwd_kernel, NWAVES * 64, LDS_BYTES) != hipSuccess || per_cu < 1) { fprintf(stderr, "kernel_launch: occupancy query says %d\n", per_cu); }
        (void)hipGetLastError();
        grid = cus;
        if (grid != 256) fprintf(stderr, "kernel_launch: %d CUs; this kernel is laid out for 256\n", grid);
        if (NTOK % (grid * NWAVES) != 0) { fprintf(stderr, "kernel_launch: grid %d does not divide the token rows\n", grid); grid = -1; return; }
    }
    if (grid < 0) return;
    if (hipMemsetAsync((char*)d_ws + WS_CTL, 0, CTL_ZERO_BYTES, stream) != hipSuccess) return;
    Args a{};
    for (int i = 0; i < 22; ++i) a.in[i] = (const float*)d_in[i];
    a.out = (float*)d_out; a.ws = (unsigned char*)d_ws;
    if (MK_N_LAUNCHES == 1) { a.ph_lo = 0; a.ph_hi = NPHASE; hipLaunchKernelGGL(fwd_kernel, dim3(grid), dim3(NWAVES * 64), LDS_BYTES, stream, a); }
    else for (int p = 0; p < NPHASE; ++p) { a.ph_lo = p; a.ph_hi = p + 1; hipLaunchKernelGGL(fwd_kernel, dim3(grid), dim3(NWAVES * 64), LDS_BYTES, stream, a); }
}
```

```cpp
#include <hip/hip_runtime.h>
#include <cstdio>
#include <cstdint>

#ifndef MK_N_LAUNCHES
#define MK_N_LAUNCHES 1
#endif

#ifndef MK_SEQ
#define MK_SEQ 0, 1, 2, 3, 4, 5, 6, 7, 8, 9, 10, 11
#endif
#define LAS __attribute__((address_space(3)))
#define GAS __attribute__((address_space(1)))
typedef unsigned short bf16;
typedef short bf16x8 __attribute__((ext_vector_type(8)));
typedef short s16x4 __attribute__((ext_vector_type(4)));
typedef float f32x4 __attribute__((ext_vector_type(4)));
typedef float f32x2 __attribute__((ext_vector_type(2)));
typedef float f32x16 __attribute__((ext_vector_type(16)));
typedef unsigned u32x4 __attribute__((ext_vector_type(4)));
typedef unsigned u32x2 __attribute__((ext_vector_type(2)));
typedef __bf16 bf16x2_t __attribute__((ext_vector_type(2)));
typedef short v4i16_t __attribute__((ext_vector_type(4)));
typedef int v8i32_t __attribute__((ext_vector_type(8)));
typedef int v8i32_a16 __attribute__((ext_vector_type(8), aligned(16)));

constexpr int NB = 4, SEQ = 8192, NTOK = NB * SEQ, DM = 2048, DIN = 5120, DG = 1024, NE = 32, DE = 1024;
constexpr int NMOD = 6 * DM;
constexpr float EPS = 1e-6f;
constexpr int PMAX = 73728;
constexpr int TMAX = PMAX / 256;
constexpr float QSCALE = 0.12751743f;

__device__ __forceinline__ unsigned cvtpk(float lo, float hi) { f32x2 v = {lo, hi}; bf16x2_t b = __builtin_convertvector(v, bf16x2_t); return __builtin_bit_cast(unsigned, b); }
__device__ __forceinline__ unsigned cvt4_fp8(float a, float b, float c, float d) { int w = 0; w = __builtin_amdgcn_cvt_pk_fp8_f32(a, b, w, false); w = __builtin_amdgcn_cvt_pk_fp8_f32(c, d, w, true); return (unsigned)w; }
__device__ __forceinline__ float bflo(unsigned w) { return __uint_as_float(w << 16); }
__device__ __forceinline__ float bfhi(unsigned w) { return __uint_as_float(w & 0xffff0000u); }
__device__ __forceinline__ float wave_sum(float v) {
#pragma unroll
    for (int o = 1; o < 64; o <<= 1) v += __shfl_xor(v, o);
    return v;
}
__device__ __forceinline__ float gelu_t(float v) { const float u = v * (1.0f + 0.044715f * v * v); const float e = __builtin_amdgcn_exp2f(-2.302208198f * u); return v * __builtin_amdgcn_rcpf(1.0f + e); }
__device__ __forceinline__ float silu_f(float v) { return v * __builtin_amdgcn_rcpf(1.0f + __builtin_amdgcn_exp2f(-1.442695041f * v)); }

namespace pg8 {
constexpr int BM = 256, BK = 64, HALF = 128, HTB = HALF * BK * 2, STAGE_BYTES = 8 * HTB, NXCD = 8, WGM = 8;
__host__ __device__ __forceinline__ int lds_byte(int r, int c) { const int st = (r >> 4) * 2 + (c >> 5), rr = r & 15, cc = c & 31, ob = rr * 64 + cc * 2; return st * 1024 + (ob ^ (((ob >> 9) & 1) << 5)); }
__host__ __device__ __forceinline__ void stage_rc(int b, int& R, int& C) { const int st = b / 1024, sb = b % 1024, swz = sb ^ (((sb >> 9) & 1) << 5); R = (st >> 1) * 16 + swz / 64; C = (st & 1) * 32 + (swz % 64) / 2; }
__host__ __device__ __forceinline__ int perm32(int rho) { const int n = rho >> 4, i = rho & 15; return 8 * (i >> 2) + 4 * n + (i & 3); }

struct Unit { int pm, pn; };
struct Gemm { const bf16* A; const bf16* Bt; int K; int lda; const int* arow; };

struct StaticOrder {
    int nM, nN, nwg, G, c;
    __device__ void init(int nM_, int nN_, int G_, int c_) { nM = nM_; nN = nN_; nwg = nM * nN; G = G_; c = c_; }
    __device__ bool next(int i, Unit& u) const {
        const long L = (long)i * G + c; if (L >= nwg) return false;
        int wgid = (int)L; { const int q = nwg / NXCD, r = nwg % NXCD, xcd = wgid % NXCD, off = wgid / NXCD; wgid = (xcd < r ? xcd * (q + 1) : r * (q + 1) + (xcd - r) * q) + off; }
        const int nig = WGM * nN, gid = wgid / nig, fm = gid * WGM, gsz = (nM - fm) < WGM ? (nM - fm) : WGM;
        u.pm = fm + ((wgid % nig) % gsz); u.pn = (wgid % nig) / gsz; return true;
    }
    __device__ __forceinline__ int bidx(const Unit& u) const { return u.pn; }
};
struct MoeOrder : StaticOrder {
    const LAS int* tile_e;
    __device__ __forceinline__ int bidx(const Unit& u) const { return tile_e[u.pm] * nN + u.pn; }
};

struct EpiInProj {
    static constexpr bool PERM = true;
    bf16* O; int ldc;
    __device__ __forceinline__ void operator()(const f32x4 (&acc)[2][2][4][2], const Unit& u, int wr, int wc, int fr, int fq) const {
        const int row0 = u.pm * BM + wr * 64 + fr, col0 = u.pn * BM + wc * 32 + 8 * fq;
        const int mode = u.pn < 8 ? 0 : (u.pn < 12 ? 1 : 2);
#pragma unroll
        for (int ai = 0; ai < 2; ++ai)
#pragma unroll
            for (int m = 0; m < 4; ++m) { bf16* rowp = O + (size_t)(row0 + ai * HALF + m * 16) * ldc + col0;
#pragma unroll
                for (int bj = 0; bj < 2; ++bj) { f32x4 v0 = acc[ai][bj][m][0], v1 = acc[ai][bj][m][1];
                    if (mode == 0) {
#pragma unroll
                        for (int j = 0; j < 4; ++j) { v0[j] = gelu_t(v0[j]); v1[j] = gelu_t(v1[j]); } }
                    else if (mode == 1) { v0 = v0 * QSCALE; v1 = v1 * QSCALE; }
                    u32x4 w; w.x = cvtpk(v0[0], v0[1]); w.y = cvtpk(v0[2], v0[3]); w.z = cvtpk(v1[0], v1[1]); w.w = cvtpk(v1[2], v1[3]);
                    *(u32x4*)(rowp + bj * HALF) = w; } }
    }
};
struct EpiPlain {
    static constexpr bool PERM = true;
    bf16* O; int ldc; float scale;
    __device__ __forceinline__ void operator()(const f32x4 (&acc)[2][2][4][2], const Unit& u, int wr, int wc, int fr, int fq) const {
        const int row0 = u.pm * BM + wr * 64 + fr, col0 = u.pn * BM + wc * 32 + 8 * fq;
#pragma unroll
        for (int ai = 0; ai < 2; ++ai)
#pragma unroll
            for (int m = 0; m < 4; ++m) { bf16* rowp = O + (size_t)(row0 + ai * HALF + m * 16) * ldc + col0;
#pragma unroll
                for (int bj = 0; bj < 2; ++bj) { const f32x4 v0 = acc[ai][bj][m][0] * scale, v1 = acc[ai][bj][m][1] * scale;
                    u32x4 w; w.x = cvtpk(v0[0], v0[1]); w.y = cvtpk(v0[2], v0[3]); w.z = cvtpk(v1[0], v1[1]); w.w = cvtpk(v1[2], v1[3]);
                    *(u32x4*)(rowp + bj * HALF) = w; } }
    }
};
struct EpiSwiglu8 {
    static constexpr bool PERM = true;
    unsigned char* O; int ldc;
    __device__ __forceinline__ void operator()(const f32x4 (&acc)[2][2][4][2], const Unit& u, int wr, int wc, int fr, int fq) const {
        const int row0 = u.pm * BM + wr * 64 + fr, col0 = u.pn * HALF + wc * 32 + 8 * fq;
#pragma unroll
        for (int ai = 0; ai < 2; ++ai)
#pragma unroll
            for (int m = 0; m < 4; ++m) { unsigned char* rowp = O + (size_t)(row0 + ai * HALF + m * 16) * ldc + col0;
                f32x4 v0, v1;
#pragma unroll
                for (int j = 0; j < 4; ++j) { v0[j] = silu_f(acc[ai][0][m][0][j] * 0.015625f) * acc[ai][1][m][0][j] * 0.0625f; v1[j] = silu_f(acc[ai][0][m][1][j] * 0.015625f) * acc[ai][1][m][1][j] * 0.0625f; }
                u32x2 w; w.x = cvt4_fp8(v0[0], v0[1], v0[2], v0[3]); w.y = cvt4_fp8(v1[0], v1[1], v1[2], v1[3]);
                *(u32x2*)rowp = w; }
    }
};
struct EpiSwiglu {
    static constexpr bool PERM = true;
    bf16* O; int ldc;
    __device__ __forceinline__ void operator()(const f32x4 (&acc)[2][2][4][2], const Unit& u, int wr, int wc, int fr, int fq) const {
        const int row0 = u.pm * BM + wr * 64 + fr, col0 = u.pn * HALF + wc * 32 + 8 * fq;
#pragma unroll
        for (int ai = 0; ai < 2; ++ai)
#pragma unroll
            for (int m = 0; m < 4; ++m) { bf16* rowp = O + (size_t)(row0 + ai * HALF + m * 16) * ldc + col0;
                f32x4 v0, v1;
#pragma unroll
                for (int j = 0; j < 4; ++j) { v0[j] = silu_f(acc[ai][0][m][0][j]) * acc[ai][1][m][0][j]; v1[j] = silu_f(acc[ai][0][m][1][j]) * acc[ai][1][m][1][j]; }
                u32x4 w; w.x = cvtpk(v0[0], v0[1]); w.y = cvtpk(v0[2], v0[3]); w.z = cvtpk(v1[0], v1[1]); w.w = cvtpk(v1[2], v1[3]);
                *(u32x4*)rowp = w; }
    }
};

template <bool FP8> struct Frag { bf16x8 v[2]; };
template <> struct Frag<true> { v8i32_t v; };
template <class Epi, class Sched, bool ALIGN_EPI, bool GATHER, bool FP8 = false>
__device__ __forceinline__ void gemm_phase(LAS unsigned char* lds, const Gemm g, const Sched& S, const Epi& E) {
    const int tid = threadIdx.x, wid = __builtin_amdgcn_readfirstlane(tid >> 6), lane = tid & 63, wr = wid >> 2, wc = wid & 3, fr = lane & 15, fq = lane >> 4;
    const int K = g.K, nt = K / BK, lda = g.lda;
    unsigned voffB[2]; int RA[2], CA[2];
    unsigned oc[2][2], on[2][2];
#pragma unroll
    for (int i = 0; i < 2; ++i) { int R, C; stage_rc(tid * 16 + i * 8192, R, C); const int Rb = Epi::PERM ? ((R & ~31) + perm32(R & 31)) : R;
        RA[i] = R; CA[i] = C; voffB[i] = (unsigned)(Rb * K + C) * 2u; }
    const size_t kstep = (size_t)(BK * 2);
    const size_t hstepB = (size_t)HALF * K * 2, tstepB = 2 * hstepB;
    const size_t tstepA = (size_t)BM * lda * 2;
    const unsigned ldsw = (unsigned)wid * 1024u;
    const int aoff = FP8 ? lds_byte(wr * 64 + fr, fq * 16) : lds_byte(wr * 64 + fr, fq * 8), boff = FP8 ? lds_byte(wc * 32 + fr, fq * 16) : lds_byte(wc * 32 + fr, fq * 8);

#define PG8_SA(b, h) (((b) * 2 + (h)) * HTB)
#define PG8_SB(b, h) ((4 + (b) * 2 + (h)) * HTB)
#define PG8_STAGE(bufoff, gbase, voff) do { _Pragma("unroll") for (int _i = 0; _i < 2; ++_i) \
        __builtin_amdgcn_global_load_lds((const unsigned*)((const char*)(gbase) + (voff)[_i]), (LAS unsigned*)(lds + (bufoff) + ldsw + _i * 8192), 16, 0, 0); } while (0)
#define PG8_LDA(dst, b, h) do { _Pragma("unroll") for (int m = 0; m < 4; ++m) { \
        if constexpr (FP8) dst[m].v = *(const LAS v8i32_a16*)(lds + PG8_SA(b, h) + aoff + m * 2048); \
        else { _Pragma("unroll") for (int k = 0; k < 2; ++k) dst[m].v[k] = *(const LAS bf16x8*)(lds + PG8_SA(b, h) + aoff + m * 2048 + k * 1024); } } } while (0)
#define PG8_LDB(dst, b, h) do { _Pragma("unroll") for (int n = 0; n < 2; ++n) { \
        if constexpr (FP8) dst[n].v = *(const LAS v8i32_a16*)(lds + PG8_SB(b, h) + boff + n * 2048); \
        else { _Pragma("unroll") for (int k = 0; k < 2; ++k) dst[n].v[k] = *(const LAS bf16x8*)(lds + PG8_SB(b, h) + boff + n * 2048 + k * 1024); } } } while (0)
#define PG8_MMA(ai, bj, At, Bt) do { __builtin_amdgcn_s_setprio(1); _Pragma("unroll") for (int m = 0; m < 4; ++m) _Pragma("unroll") for (int n = 0; n < 2; ++n) { \
        if constexpr (FP8) asm volatile("v_mfma_scale_f32_16x16x128_f8f6f4 %0, %1, %2, %0, %3, %3 op_sel_hi:[0,0,0]" : "+v"(acc[ai][bj][m][n]) : "v"(Bt[n].v), "v"(At[m].v), "v"(sc1));   \
        else { _Pragma("unroll") for (int k = 0; k < 2; ++k) acc[ai][bj][m][n] = __builtin_amdgcn_mfma_f32_16x16x32_bf16(Bt[n].v[k], At[m].v[k], acc[ai][bj][m][n], 0, 0, 0); } } \
        __builtin_amdgcn_s_setprio(0); } while (0)
#define PG8_WAIT_V(n) asm volatile("s_waitcnt vmcnt(" #n ")" ::: "memory")
#define PG8_WAIT_L(n) asm volatile("s_waitcnt lgkmcnt(" #n ")" ::: "memory")
#define PG8_BAR __builtin_amdgcn_s_barrier()
#define PG8_SCHED __builtin_amdgcn_sched_barrier(0)
#define PG8_AOFF(dst, pm_) do { _Pragma("unroll") for (int _h = 0; _h < 2; ++_h) _Pragma("unroll") for (int _i = 0; _i < 2; ++_i) { \
        if constexpr (GATHER) dst[_h][_i] = ((unsigned)g.arow[(pm_) * BM + _h * HALF + RA[_i]] * (unsigned)lda + (unsigned)CA[_i]) * 2u; \
        else dst[_h][_i] = ((unsigned)(_h * HALF + RA[_i]) * (unsigned)lda + (unsigned)CA[_i]) * 2u; } } while (0)
    Unit cur, nxt; int ui = 0;
    if (!S.next(0, cur)) return;
    f32x4 acc[2][2][4][2];
#pragma unroll
    for (int a = 0; a < 2; ++a)
#pragma unroll
        for (int b = 0; b < 2; ++b)
#pragma unroll
            for (int m = 0; m < 4; ++m)
#pragma unroll
                for (int n = 0; n < 2; ++n) acc[a][b][m][n] = (f32x4){0.f, 0.f, 0.f, 0.f};
    Frag<FP8> At[4], B0[2], B1[2];
    const int sc1 = 0x7f7f7f7f;
    PG8_AOFF(oc, cur.pm);
    const char* cA = (const char*)g.A + (GATHER ? (size_t)0 : (size_t)cur.pm * tstepA); const char* cB = (const char*)g.Bt + (size_t)S.bidx(cur) * tstepB;
    PG8_STAGE(PG8_SB(0, 0), cB, voffB); PG8_STAGE(PG8_SB(0, 1), cB + hstepB, voffB); PG8_STAGE(PG8_SA(0, 0), cA, oc[0]); PG8_STAGE(PG8_SA(0, 1), cA, oc[1]);
    if (wr == 1) PG8_BAR;
    PG8_WAIT_V(2); PG8_BAR;
    PG8_STAGE(PG8_SB(1, 0), cB + kstep, voffB); PG8_STAGE(PG8_SA(1, 0), cA + kstep, oc[0]); PG8_STAGE(PG8_SB(1, 1), cB + hstepB + kstep, voffB);
    PG8_WAIT_V(6); PG8_BAR;
    for (;;) {
        const bool has_next = S.next(ui + 1, nxt);
        const char* nA = cA; const char* nB = cB;
        if (has_next) { nA = (const char*)g.A + (GATHER ? (size_t)0 : (size_t)nxt.pm * tstepA); nB = (const char*)g.Bt + (size_t)S.bidx(nxt) * tstepB; PG8_AOFF(on, nxt.pm); }
        else {
#pragma unroll
            for (int h = 0; h < 2; ++h)
#pragma unroll
                for (int i = 0; i < 2; ++i) on[h][i] = oc[h][i]; }
        for (int t = 0; t < nt; t += 2) {
            const bool last = (t == nt - 2);
            const char* a1 = cA + (size_t)(t + 1) * kstep;
            const char* a2 = last ? nA : cA + (size_t)(t + 2) * kstep; const char* b2 = last ? nB : cB + (size_t)(t + 2) * kstep;
            const char* a3 = a2 + kstep; const char* b3 = b2 + kstep;
            unsigned o2[2][2];
#pragma unroll
            for (int h = 0; h < 2; ++h)
#pragma unroll
                for (int i = 0; i < 2; ++i) o2[h][i] = last ? on[h][i] : oc[h][i];
            PG8_LDB(B0, 0, 0); PG8_LDB(B1, 0, 1); PG8_SCHED; PG8_LDA(At, 0, 0); PG8_STAGE(PG8_SA(1, 1), a1, oc[1]);
            PG8_WAIT_V(8); PG8_WAIT_L(0); PG8_BAR; PG8_MMA(0, 0, At, B0); PG8_MMA(0, 1, At, B1); PG8_BAR; PG8_SCHED;
            PG8_LDA(At, 0, 1); PG8_STAGE(PG8_SB(0, 0), b2, voffB); PG8_STAGE(PG8_SB(0, 1), b2 + hstepB, voffB); PG8_STAGE(PG8_SA(0, 0), a2, o2[0]);
            PG8_WAIT_V(8); PG8_WAIT_L(0); PG8_BAR; PG8_MMA(1, 0, At, B0); PG8_MMA(1, 1, At, B1); PG8_BAR; PG8_SCHED;
            PG8_LDB(B0, 1, 0); PG8_LDB(B1, 1, 1); PG8_SCHED; PG8_LDA(At, 1, 0); PG8_STAGE(PG8_SA(0, 1), a2, o2[1]);
            PG8_WAIT_V(8); PG8_WAIT_L(0); PG8_BAR; PG8_MMA(0, 0, At, B0); PG8_MMA(0, 1, At, B1); PG8_BAR; PG8_SCHED;
            PG8_LDA(At, 1, 1); PG8_STAGE(PG8_SB(1, 0), b3, voffB); PG8_STAGE(PG8_SB(1, 1), b3 + hstepB, voffB); PG8_STAGE(PG8_SA(1, 0), a3, o2[0]);
            PG8_WAIT_V(8); PG8_WAIT_L(0); PG8_BAR; PG8_MMA(1, 0, At, B0); PG8_MMA(1, 1, At, B1); PG8_BAR; PG8_SCHED;
        }
        if constexpr (FP8) asm volatile("s_nop 15\n\ts_nop 15" ::: "memory");
        if constexpr (ALIGN_EPI) { if (wr == 0) PG8_BAR; }
        E(acc, cur, wr, wc, fr, fq);
        if (!has_next) break;
#pragma unroll
        for (int a = 0; a < 2; ++a)
#pragma unroll
            for (int b = 0; b < 2; ++b)
#pragma unroll
                for (int m = 0; m < 4; ++m)
#pragma unroll
                    for (int n = 0; n < 2; ++n) acc[a][b][m][n] = (f32x4){0.f, 0.f, 0.f, 0.f};
        cur = nxt; cA = nA; cB = nB; ++ui;
#pragma unroll
        for (int h = 0; h < 2; ++h)
#pragma unroll
            for (int i = 0; i < 2; ++i) oc[h][i] = on[h][i];
        if constexpr (ALIGN_EPI) { if (wr == 1) PG8_BAR; }
    }
    PG8_WAIT_V(0);
    if constexpr (!ALIGN_EPI) { if (wr == 0) PG8_BAR; }
    PG8_BAR;
#undef PG8_SA
#undef PG8_SB
#undef PG8_STAGE
#undef PG8_LDA
#undef PG8_LDB
#undef PG8_MMA
#undef PG8_WAIT_V
#undef PG8_WAIT_L
#undef PG8_BAR
#undef PG8_SCHED
#undef PG8_AOFF
}
}

constexpr size_t MiB = 1u << 20;
constexpr size_t WS_CTL = 0, CTL_ZERO_BYTES = 1 * MiB;
constexpr size_t WS_ROWTOK = 65536;
constexpr size_t WS_MOD = 1 * MiB;
constexpr size_t WS_WSM = 1 * MiB + 256 * 1024;
constexpr size_t WS_YASS = 1 * MiB + 512 * 1024;
constexpr size_t WS_EID = 1 * MiB + 768 * 1024;
constexpr size_t WS_LRANK = 2 * MiB;
constexpr size_t WS_WT = 2 * MiB + 256 * 1024;
constexpr size_t WS_TOKPOS = 2 * MiB + 512 * 1024;
constexpr size_t WS_LCNT = 2 * MiB + 768 * 1024;
constexpr size_t WS_ML = 3 * MiB;
constexpr size_t WS_WRF = 9 * MiB;
constexpr size_t WS_WIN = 10 * MiB;
constexpr size_t WS_WOUT = 30 * MiB;
constexpr size_t WS_WGU = 38 * MiB;
constexpr size_t WS_WDN = 166 * MiB;
constexpr size_t WS_HB = 230 * MiB;
constexpr size_t WS_PROJ = 358 * MiB;
constexpr size_t WS_OPART = 678 * MiB;
constexpr size_t WS_Y1 = 870 * MiB;
constexpr size_t WS_ACT = 358 * MiB;
constexpr size_t WS_YBUF = 430 * MiB;
constexpr size_t WS_END = 998 * MiB;
static_assert(WS_ROWTOK + (size_t)PMAX * 4 <= CTL_ZERO_BYTES, "ROWTOK inside the memset region");
static_assert(WS_ACT + (size_t)PMAX * DE <= WS_YBUF && WS_YBUF + (size_t)PMAX * DM * 2 <= WS_Y1 && WS_OPART + (size_t)3 * NTOK * 1024 * 2 <= WS_Y1 && WS_WDN + (size_t)NE * DM * DE <= WS_HB, "d_ws map");
constexpr int CW_BAR = 4096;

constexpr int RING_BYTES = 155648;
constexpr int MISC_OFF = RING_BYTES;
constexpr int XTRA_OFF = MISC_OFF + 2048;
constexpr int LDS_BYTES = 163840;
constexpr int NWAVES = 8;
constexpr int NPHASE = 12;

#define RLX_AGENT __ATOMIC_RELAXED, __HIP_MEMORY_SCOPE_AGENT
#define XB_TMO      128
#define XB_XCNT(j)  (256  + 64 * (j))
#define XB_XSUB(j)  (1280 + 64 * (j))
#define XB_XGEN(j)  (2304 + 64 * (j))
#define XB_TOP      3328
#define XB_TOPGEN   3392
#define XCD_BAR_WORDS 3456
#define XB_SPIN_CAP (1u << 18)
__device__ __forceinline__ unsigned xb_ld(unsigned* p)              { return __hip_atomic_load(p, __ATOMIC_RELAXED, __HIP_MEMORY_SCOPE_AGENT); }
__device__ __forceinline__ unsigned xb_add(unsigned* p, unsigned v) { return __hip_atomic_fetch_add(p, v, __ATOMIC_RELAXED, __HIP_MEMORY_SCOPE_AGENT); }
__device__ __forceinline__ unsigned xb_xcc_id() { return (unsigned)__builtin_amdgcn_s_getreg((3 << 11) | 20) & 0xFu; }
#define XB_SPIN(cond, bar) do { unsigned _sp = 0; while (cond) { __builtin_amdgcn_s_sleep(1); \
    if ((++_sp & 255u) == 0u) { if (xb_ld(&(bar)[XB_TMO])) break; if (_sp > XB_SPIN_CAP) { atomicAdd(&(bar)[XB_TMO], 1u); break; } } } } while (0)
struct XcdBarrier { unsigned* bar; unsigned x; volatile LAS unsigned* st; };
__device__ __forceinline__ XcdBarrier xcd_barrier_post(unsigned* bar, volatile LAS unsigned* st) {
    XcdBarrier b; b.bar = bar; b.x = xb_xcc_id(); b.st = st;
    if (threadIdx.x == 0) (void)xb_add(&bar[XB_XCNT(b.x)], 1u);
    return b;
}
__device__ __forceinline__ void xcd_barrier_complete(unsigned* bar, unsigned x, unsigned& nloc, unsigned& nx) {
    const unsigned G = gridDim.x * gridDim.y * gridDim.z;
    unsigned sum, cnt, mine, sp = 0u;
    for (;;) {
        sum = 0u; cnt = 0u; mine = 0u;
#pragma unroll
        for (unsigned j = 0; j < 16; ++j) { const unsigned c = xb_ld(&bar[XB_XCNT(j)]); sum += c; cnt += (c > 0u) ? 1u : 0u; mine = (j == x) ? c : mine; }
        if (sum == G) break;
        __builtin_amdgcn_s_sleep(1);
        if ((++sp & 255u) == 0u) { if (xb_ld(&bar[XB_TMO])) break; if (sp > XB_SPIN_CAP) { atomicAdd(&bar[XB_TMO], 1u); break; } }
    }
    nloc = mine > 0u ? mine : 1u; nx = cnt > 0u ? cnt : 1u;
}
__device__ __forceinline__ void xcd_barrier(const XcdBarrier& b) {
    asm volatile("s_waitcnt vmcnt(0)" ::: "memory");
    __syncthreads();
    if (threadIdx.x == 0) {
        unsigned* bar = b.bar;
        __builtin_amdgcn_s_waitcnt(0);
        unsigned nloc = b.st[0], nx = b.st[1];
        if (nloc == 0u) { xcd_barrier_complete(bar, b.x, nloc, nx); b.st[0] = nloc; b.st[1] = nx; }
        const unsigned old = xb_add(&bar[XB_XSUB(b.x)], 1u);
        const unsigned gen = old / nloc;
        if (old + 1u == (gen + 1u) * nloc) {
            __builtin_amdgcn_fence(__ATOMIC_RELEASE, "agent");
            asm volatile("s_waitcnt vmcnt(0)" ::: "memory");
            const unsigned og = xb_add(&bar[XB_TOP], 1u);
            const unsigned tg = og / nx;
            if (og + 1u == (tg + 1u) * nx) xb_add(&bar[XB_TOPGEN], 1u);
            else XB_SPIN(xb_ld(&bar[XB_TOPGEN]) == tg, bar);
            __builtin_amdgcn_fence(__ATOMIC_ACQUIRE, "agent");
            xb_add(&bar[XB_XGEN(b.x)], 1u);
            asm volatile("s_waitcnt vmcnt(0)" ::: "memory");
        } else {
            XB_SPIN(xb_ld(&bar[XB_XGEN(b.x)]) == gen, bar);
            __builtin_amdgcn_fence(__ATOMIC_ACQUIRE, "agent");
            asm volatile("s_waitcnt vmcnt(0)" ::: "memory");
        }
    }
    __syncthreads();
}

__device__ __forceinline__ s16x4 vtr(const LAS unsigned char* p) { return __builtin_bit_cast(s16x4, __builtin_amdgcn_ds_read_tr16_b64_v4i16((LAS v4i16_t*)p)); }
#define MFMA32(a, b, c) __builtin_amdgcn_mfma_f32_32x32x16_bf16((a), (b), (c), 0, 0, 0)
__device__ __forceinline__ int crow(int r, int hi) { return (r & 3) + 8 * (r >> 2) + 4 * hi; }
__device__ __forceinline__ void unpack8(const u32x4 w, float (&f)[8]) { f[0] = bflo(w.x); f[1] = bfhi(w.x); f[2] = bflo(w.y); f[3] = bfhi(w.y); f[4] = bflo(w.z); f[5] = bfhi(w.z); f[6] = bflo(w.w); f[7] = bfhi(w.w); }
__device__ __forceinline__ u32x4 pack8(const float (&f)[8]) { u32x4 w; w.x = cvtpk(f[0], f[1]); w.y = cvtpk(f[2], f[3]); w.z = cvtpk(f[4], f[5]); w.w = cvtpk(f[6], f[7]); return w; }

struct Args { const float* in[22]; float* out; unsigned char* ws; int ph_lo, ph_hi; };

__device__ __forceinline__ void transpose_item(const float* W, int N, int k0, int n0, bf16* dst, int ldk, LAS float* scr, int lane) {
    const int cl = lane & 15, kq = lane >> 4;
#pragma unroll 4
    for (int i = 0; i < 16; ++i) { const int kk = 4 * i + kq; const f32x4 v = *(const f32x4*)(W + (size_t)(k0 + kk) * N + n0 + 4 * cl);
        LAS float* s = scr + kk * 65 + 4 * cl; s[0] = v[0]; s[1] = v[1]; s[2] = v[2]; s[3] = v[3]; }
    asm volatile("s_waitcnt lgkmcnt(0)" ::: "memory");
    const int c = lane >> 3, nn = lane & 7;
#pragma unroll
    for (int it = 0; it < 8; ++it) { const int n = nn + 8 * it; const LAS float* s = scr + (8 * c) * 65 + n;
        u32x4 o; o.x = cvtpk(s[0], s[65]); o.y = cvtpk(s[2 * 65], s[3 * 65]); o.z = cvtpk(s[4 * 65], s[5 * 65]); o.w = cvtpk(s[6 * 65], s[7 * 65]);
        *(u32x4*)(dst + (size_t)n * ldk + k0 + 8 * c) = o; }
    asm volatile("s_waitcnt lgkmcnt(0)" ::: "memory");
}

__device__ __forceinline__ void transpose_item8(const float* W, int N, int k0, int n0, unsigned char* dst, int ldk, LAS float* scr, int lane) {
    const int cl = lane & 15, kq = lane >> 4;
#pragma unroll 4
    for (int i = 0; i < 16; ++i) { const int kk = 4 * i + kq; const f32x4 v = *(const f32x4*)(W + (size_t)(k0 + kk) * N + n0 + 4 * cl);
        LAS float* s = scr + kk * 65 + 4 * cl; s[0] = v[0]; s[1] = v[1]; s[2] = v[2]; s[3] = v[3]; }
    asm volatile("s_waitcnt lgkmcnt(0)" ::: "memory");
    const int c = lane >> 4, nn = lane & 15;
#pragma unroll
    for (int it = 0; it < 4; ++it) { const int n = nn + 16 * it; const LAS float* s = scr + (16 * c) * 65 + n; u32x4 o;
        o.x = cvt4_fp8(64.f * s[0], 64.f * s[65], 64.f * s[2 * 65], 64.f * s[3 * 65]); o.y = cvt4_fp8(64.f * s[4 * 65], 64.f * s[5 * 65], 64.f * s[6 * 65], 64.f * s[7 * 65]);
        o.z = cvt4_fp8(64.f * s[8 * 65], 64.f * s[9 * 65], 64.f * s[10 * 65], 64.f * s[11 * 65]); o.w = cvt4_fp8(64.f * s[12 * 65], 64.f * s[13 * 65], 64.f * s[14 * 65], 64.f * s[15 * 65]);
        *(u32x4*)(dst + (size_t)n * ldk + k0 + 16 * c) = o; }
    asm volatile("s_waitcnt lgkmcnt(0)" ::: "memory");
}

__device__ __forceinline__ void build_tiles(const int* lcnt, int G, int c, LAS unsigned char* lds, bool want_base) {
    LAS int* tot = (LAS int*)(lds + MISC_OFF + 1792); LAS int* wof = tot + 32;
    LAS int* ttab = (LAS int*)(lds + MISC_OFF + 256); LAS int* base = (LAS int*)(lds + MISC_OFF + 1536);
    const int tid = threadIdx.x;
    if (tid < 32) { int t = 0, b = 0; for (int w = 0; w < G; ++w) { const int v = lcnt[w * 32 + tid]; t += v; if (w < c) b += v; } tot[tid] = t; wof[tid] = b; }
    __syncthreads();
    if (tid == 0) { int ts = 0; for (int e = 0; e < 32; ++e) { const int nt = (tot[e] + 255) >> 8; for (int j = 0; j < nt; ++j) ttab[1 + ts + j] = e; if (want_base) base[e] = ts * 256 + wof[e]; ts += nt; } ttab[0] = ts; }
    __syncthreads();
}

__global__ void __launch_bounds__(NWAVES * 64, 2) fwd_kernel(Args args) {
    extern __shared__ __attribute__((aligned(16))) unsigned char lds_raw[];
    LAS unsigned char* lds = (LAS unsigned char*)lds_raw;
    const int tid = threadIdx.x, lane = tid & 63, wave = __builtin_amdgcn_readfirstlane(tid >> 6);
    const int G = gridDim.x, c = blockIdx.x;
    const int gw = c * NWAVES + wave, NGW = G * NWAVES;
    unsigned char* ws = args.ws;
    unsigned* ctl = (unsigned*)(ws + WS_CTL);
    const float* x = args.in[0]; const float* cvec = args.in[1]; const float* w_mod = args.in[2]; const float* b_mod = args.in[3];
    const float* g_pre_mix = args.in[4]; const float* g_post_mix = args.in[5]; const float* w_in = args.in[6]; const float* g_gmlp_v = args.in[7];
    const float* w_spatial = args.in[8]; const float* b_spatial = args.in[9]; const float* g_out_gmlp = args.in[10]; const float* g_out_attn = args.in[11];
    const float* w_out = args.in[12]; const float* g_pre_ffn = args.in[13]; const float* g_post_ffn = args.in[14];
    const float* w_rg = args.in[15]; const float* b_rg = args.in[16]; const float* w_re = args.in[17]; const float* b_re = args.in[18];
    const float* w_gate = args.in[19]; const float* w_up = args.in[20]; const float* w_down = args.in[21];
    float* out = args.out;
    int* ROWTOK = (int*)(ws + WS_ROWTOK); float* MOD = (float*)(ws + WS_MOD); bf16* WSM = (bf16*)(ws + WS_WSM); float* YASS = (float*)(ws + WS_YASS);
    int* EID = (int*)(ws + WS_EID); int* LRANK = (int*)(ws + WS_LRANK); float* WT = (float*)(ws + WS_WT); int* TOKPOS = (int*)(ws + WS_TOKPOS); int* LCNT = (int*)(ws + WS_LCNT);
    float* ML = (float*)(ws + WS_ML); bf16* WRF = (bf16*)(ws + WS_WRF);
    bf16* WIN = (bf16*)(ws + WS_WIN); bf16* WOUT = (bf16*)(ws + WS_WOUT); unsigned char* WGU = ws + WS_WGU; unsigned char* WDN = ws + WS_WDN; unsigned char* HB8 = ws + WS_HB;
    bf16* HB = (bf16*)(ws + WS_HB); bf16* PROJ = (bf16*)(ws + WS_PROJ); bf16* OPART = (bf16*)(ws + WS_OPART); bf16* Y1 = (bf16*)(ws + WS_Y1);
    unsigned char* ACT = ws + WS_ACT; bf16* YBUF = (bf16*)(ws + WS_YBUF);

    for (int u = tid; u < 2048 / 4; u += NWAVES * 64) ((LAS unsigned*)(lds + MISC_OFF))[u] = 0u;
    __syncthreads();
    XcdBarrier bar; bar.bar = ctl + CW_BAR; bar.x = 0; bar.st = nullptr;
    if (MK_N_LAUNCHES == 1) bar = xcd_barrier_post(ctl + CW_BAR, (volatile LAS unsigned*)(lds + MISC_OFF));
    const int lo = args.ph_lo, hi = args.ph_hi;
#define IN(k) (lo <= (k) && (k) < hi)
#define SEAM(k) do { if (MK_N_LAUNCHES == 1 && IN(k) && IN((k) + 1)) xcd_barrier(bar); } while (0)

    if (IN(0)) {
        {
            LAS float* sc = (LAS float*)lds; LAS float* red = (LAS float*)(lds + 32768);
            const int kg = tid >> 4, cl = tid & 15;
            for (int u = c; u < NMOD / 64; u += G) {
                const int n0 = u * 64;
                for (int i = tid; i < NB * DM; i += 512) sc[i] = silu_f(cvec[i]);
                __syncthreads();
                float acc[4][4];
#pragma unroll
                for (int b = 0; b < 4; ++b)
#pragma unroll
                    for (int j = 0; j < 4; ++j) acc[b][j] = 0.f;
#pragma unroll 4
                for (int k = kg; k < DM; k += 32) { const f32x4 w = *(const f32x4*)(w_mod + (size_t)k * NMOD + n0 + 4 * cl);
#pragma unroll
                    for (int b = 0; b < 4; ++b) { const float s = sc[b * DM + k];
#pragma unroll
                        for (int j = 0; j < 4; ++j) acc[b][j] += s * w[j]; } }
#pragma unroll
                for (int b = 0; b < 4; ++b)
#pragma unroll
                    for (int j = 0; j < 4; ++j) red[(kg * 4 + b) * 64 + 4 * cl + j] = acc[b][j];
                __syncthreads();
                if (tid < 256) { const int b = tid >> 6, n = tid & 63; float s = 0.f; for (int q = 0; q < 32; ++q) s += red[(q * 4 + b) * 64 + n]; MOD[b * NMOD + n0 + n] = s + b_mod[n0 + n]; }
                __syncthreads();
            }
        }
        {
            LAS float* scr = (LAS float*)(lds + wave * 16640);
            constexpr int I_IN = 32 * 80, I_OUT = 32 * 32, I_G = 32 * 16 * 32, I_D = 16 * 32 * 32;
            constexpr int NITEMS = I_IN + I_OUT + 2 * I_G + I_D;
            for (int it = gw; it < NITEMS; it += NGW) {
                int r = it;
                if (r < I_IN) { const int kb = r / 80, nb = r % 80; transpose_item(w_in, DIN, kb * 64, nb * 64, WIN + (size_t)(nb * 64) * DM, DM, scr, lane); continue; } r -= I_IN;
                if (r < I_OUT) { const int kb = r / 32, nb = r % 32; transpose_item(w_out, DM, kb * 64, nb * 64, WOUT + (size_t)(nb * 64) * DM, DM, scr, lane); continue; } r -= I_OUT;
                if (r < 2 * I_G) { const int up = r >= I_G; if (up) r -= I_G; const int e = r / 512, q = r % 512, kb = q / 16, nb = q % 16, n0 = nb * 64;
                    const float* W = (up ? w_up : w_gate) + (size_t)e * DM * DE;
                    const size_t row0 = (size_t)(e * 8 + (n0 >> 7)) * 256 + (n0 & 127) + (up ? 128 : 0);
                    transpose_item8(W, DE, kb * 64, n0, WGU + row0 * DM, DM, scr, lane); continue; } r -= 2 * I_G;
                { const int e = r / 512, q = r % 512, kb = q / 32, nb = q % 32; const float* W = w_down + (size_t)e * DE * DM;
                  transpose_item8(W, DM, kb * 64, nb * 64, WDN + ((size_t)e * DM + nb * 64) * DE, DE, scr, lane); }
            }
        }
        for (int i = c * 512 + tid; i < 8 * 128 * 128; i += G * 512) { const int s = i & 127, t = (i >> 7) & 127; const float v = s <= t ? w_spatial[i] : 0.f; WSM[i] = (bf16)(cvtpk(v, 0.f) & 0xffffu); }
        for (int i = c * 512 + tid; i < 384 * 64; i += G * 512) {
            const int fl = i & 63, frag = i >> 6, part = frag & 1, nt = (frag >> 1) % 3, ks = (frag >> 1) / 3, n = 16 * nt + (fl & 15); float f[8];
#pragma unroll
            for (int j = 0; j < 8; ++j) { const int k = 32 * ks + 8 * (fl >> 4) + j; float w = 0.f;
                if (n < 4) w = w_rg[(size_t)k * 4 + n]; else if (n < 36) w = w_re[((size_t)((n - 4) >> 3) * DM + k) * 8 + ((n - 4) & 7)];
                const float hi = bflo(cvtpk(w, 0.f)); f[j] = part ? (w - hi) : hi; }
            *(u32x4*)(WRF + (size_t)i * 8) = pack8(f); }
    }
    SEAM(0);

    if (IN(1)) {
        const int RPW = NTOK / NGW, row0 = gw * RPW, b = row0 / SEQ;
        float av[32], sv[32];
#pragma unroll
        for (int j = 0; j < 4; ++j)
#pragma unroll
            for (int i = 0; i < 8; ++i) { const int ch = 512 * j + 8 * lane + i; av[8 * j + i] = g_pre_mix[ch] * (1.0f + MOD[b * NMOD + 1 * DM + ch]); sv[8 * j + i] = MOD[b * NMOD + 0 * DM + ch]; }
        for (int r = 0; r < RPW; ++r) {
            const float* xr = x + (size_t)(row0 + r) * DM; float xv[32]; float ss = 0.f;
#pragma unroll
            for (int j = 0; j < 4; ++j) { const f32x4 a = *(const f32x4*)(xr + 512 * j + 8 * lane), bq = *(const f32x4*)(xr + 512 * j + 8 * lane + 4);
#pragma unroll
                for (int i = 0; i < 4; ++i) { xv[8 * j + i] = a[i]; xv[8 * j + 4 + i] = bq[i]; ss += a[i] * a[i] + bq[i] * bq[i]; } }
            const float rstd = __builtin_amdgcn_rsqf(wave_sum(ss) * (1.0f / DM) + EPS);
            bf16* hr = HB + (size_t)(row0 + r) * DM;
#pragma unroll
            for (int j = 0; j < 4; ++j) { float f[8];
#pragma unroll
                for (int i = 0; i < 8; ++i) f[i] = xv[8 * j + i] * rstd * av[8 * j + i] + sv[8 * j + i];
                *(u32x4*)(hr + 512 * j + 8 * lane) = pack8(f); }
        }
    }
    SEAM(1);

    if (IN(2)) {
        pg8::Gemm g{HB, WIN, DM, DM, nullptr}; pg8::StaticOrder S; S.init(NTOK / 256, DIN / 256, G, c);
        pg8::EpiInProj E{PROJ, DIN};
        pg8::gemm_phase<pg8::EpiInProj, pg8::StaticOrder, true, false>(lds, g, S, E);
    }
    SEAM(2);

    if (IN(3)) {
        {
            LAS unsigned char* VT = lds; LAS f32x2* stats = (LAS f32x2*)(lds + 81920); LAS float* ssqL = (LAS float*)(lds + 83968);
            const int r32 = lane & 31, hh2 = lane >> 5, blk = (lane >> 4) & 1, q4 = (lane & 15) >> 2, p4 = lane & 3;
            const int tb = wave & 3, dh = wave >> 2;
            for (int u = c; u < NTOK / 128; u += G) {
                const int t0 = u * 128;
                for (int rr = 0; rr < 16; ++rr) {
                    const int row = 16 * wave + rr; const bf16* p = PROJ + (size_t)(t0 + row) * DIN + DG + 16 * lane;
                    const u32x4 a = *(const u32x4*)p, bq = *(const u32x4*)(p + 8); float f[8], g2[8]; unpack8(a, f); unpack8(bq, g2);
                    float s = 0.f, s2 = 0.f;
#pragma unroll
                    for (int i = 0; i < 8; ++i) { s += f[i] + g2[i]; s2 += f[i] * f[i] + g2[i] * g2[i]; }
                    s = wave_sum(s); s2 = wave_sum(s2);
                    const float mean = s * (1.0f / DG), var = s2 * (1.0f / DG) - mean * mean;
                    if (lane == 0) stats[row] = (f32x2){mean, __builtin_amdgcn_rsqf(fmaxf(var, 0.f) + EPS)};
                }
                __syncthreads();
                float ssq = 0.f;
#define P3_STAGE(hh, buf) do { _Pragma("unroll") for (int q = 0; q < 4; ++q) { const int idx = tid + 512 * q, s = idx >> 4, ch = idx & 15; \
                    const u32x4 raw = *(const u32x4*)(PROJ + (size_t)(t0 + s) * DIN + DG + (hh) * 128 + 8 * ch); float f[8]; unpack8(raw, f); \
                    const f32x2 st = stats[s]; const f32x4 ga = *(const f32x4*)(g_gmlp_v + (hh) * 128 + 8 * ch), gb = *(const f32x4*)(g_gmlp_v + (hh) * 128 + 8 * ch + 4); \
                    _Pragma("unroll") for (int i = 0; i < 4; ++i) { f[i] = (f[i] - st.x) * st.y * ga[i]; f[4 + i] = (f[4 + i] - st.x) * st.y * gb[i]; } \
                    *(LAS u32x4*)(VT + (buf) * 40960 + s * 320 + ch * 16) = pack8(f); } } while (0)
                P3_STAGE(0, 0);
                __syncthreads();
                for (int hh = 0; hh < 8; ++hh) {
                    const int buf = hh & 1;
                    if (hh + 1 < 8) P3_STAGE(hh + 1, buf ^ 1);
                    f32x16 acc0 = {}, acc1 = {};
                    const int nks = 2 * (tb + 1);
                    const bf16* wrow = WSM + ((size_t)(hh * 128 + 32 * tb + r32)) * 128 + 8 * hh2;
                    const LAS unsigned char* vb = VT + buf * 40960 + (8 * hh2 + q4) * 320 + (64 * dh + 16 * blk + 4 * p4) * 2;
                    for (int ks = 0; ks < nks; ++ks) {
                        const bf16x8 bw = *(const bf16x8*)(wrow + 16 * ks);
                        const LAS unsigned char* vk = vb + ks * 16 * 320;
                        const s16x4 l0 = vtr(vk), h0 = vtr(vk + 4 * 320), l1 = vtr(vk + 64), h1 = vtr(vk + 4 * 320 + 64);
                        const bf16x8 a0 = {l0[0], l0[1], l0[2], l0[3], h0[0], h0[1], h0[2], h0[3]}, a1 = {l1[0], l1[1], l1[2], l1[3], h1[0], h1[1], h1[2], h1[3]};
                        acc0 = MFMA32(a0, bw, acc0); acc1 = MFMA32(a1, bw, acc1);
                    }
                    const int tok = t0 + 32 * tb + r32; const float bsp = b_spatial[hh * 128 + 32 * tb + r32];
                    bf16* urow = PROJ + (size_t)tok * DIN + hh * 128 + 64 * dh + 4 * hh2;
#pragma unroll
                    for (int db = 0; db < 2; ++db)
#pragma unroll
                        for (int gq = 0; gq < 4; ++gq) { bf16* p = urow + 32 * db + 8 * gq; const u32x2 uu = *(const u32x2*)p;
                            const f32x16& A = db ? acc1 : acc0;
                            const float y0 = bflo(uu.x) * (A[4 * gq + 0] + bsp), y1 = bfhi(uu.x) * (A[4 * gq + 1] + bsp), y2 = bflo(uu.y) * (A[4 * gq + 2] + bsp), y3 = bfhi(uu.y) * (A[4 * gq + 3] + bsp);
                            u32x2 o; o.x = cvtpk(y0, y1); o.y = cvtpk(y2, y3);
                            const float r0 = bflo(o.x), r1 = bfhi(o.x), r2 = bflo(o.y), r3 = bfhi(o.y); ssq += r0 * r0 + r1 * r1 + r2 * r2 + r3 * r3;
                            *(u32x2*)p = o; }
                    __syncthreads();
                }
#undef P3_STAGE
                ssq += __shfl_xor(ssq, 32);
                if (lane < 32) ssqL[wave * 32 + lane] = ssq;
                __syncthreads();
                if (tid < 128) YASS[t0 + tid] = ssqL[(tid >> 5) * 32 + (tid & 31)] + ssqL[((tid >> 5) + 4) * 32 + (tid & 31)];
                __syncthreads();
            }
        }
    }
    if (IN(4)) {
        {
            LAS unsigned char* VT = lds;
            const int r32 = lane & 31, hh2 = lane >> 5, blk = (lane >> 4) & 1, q4 = (lane & 15) >> 2, p4 = lane & 3;
            for (int uid = c; uid < 3072; uid += G) {
                const int pat = uid >> 10, rem = uid & 1023, bh = rem >> 5, xq = rem & 31;
                const int dl = pat == 0 ? 1 : (pat == 1 ? 4 : 16), nblk = 32 / dl, res = xq / nblk, qb = xq % nblk;
                const int b = bh >> 3, head = bh & 7;
                const size_t tbase = (size_t)b * SEQ + res;
                const bf16* Pq = PROJ + 2048 + head * 128, * Pk = PROJ + 3072 + head * 128, * Pv = PROJ + 4096 + head * 128;
                {
                    u32x4 tmp[12];
#pragma unroll
                    for (int q = 0; q < 12; ++q) { const int idx = tid + 512 * q, i = idx >> 4, ch = idx & 15; int mk = 256 * qb - 128 + i; mk = mk < 0 ? 0 : mk;
                        tmp[q] = *(const u32x4*)(Pv + (tbase + (size_t)mk * dl) * DIN + 8 * ch); }
#pragma unroll
                    for (int q = 0; q < 12; ++q) { const int idx = tid + 512 * q, i = idx >> 4, ch = idx & 15; *(LAS u32x4*)(VT + i * 320 + ch * 16) = tmp[q]; }
                }
                const int mq = 256 * qb + 32 * wave + r32;
                const bf16* qrow = Pq + (tbase + (size_t)mq * dl) * DIN + 8 * hh2;
                bf16x8 qf[8];
#pragma unroll
                for (int d0 = 0; d0 < 8; ++d0) qf[d0] = *(const bf16x8*)(qrow + 16 * d0);
                const int mk0 = 256 * qb + 32 * wave - 128;
                f32x16 S[5];
#pragma unroll
                for (int kb = 0; kb < 5; ++kb) {
                    int mk = mk0 + 32 * kb + r32; mk = mk < 0 ? 0 : mk;
                    const bf16* krow = Pk + (tbase + (size_t)mk * dl) * DIN + 8 * hh2;
                    bf16x8 kf[8];
#pragma unroll
                    for (int d0 = 0; d0 < 8; ++d0) kf[d0] = *(const bf16x8*)(krow + 16 * d0);
                    f32x16 a = {};
#pragma unroll
                    for (int d0 = 0; d0 < 8; ++d0) a = MFMA32(kf[d0], qf[d0], a);
                    S[kb] = a;
                }
                float mx = -INFINITY;
#pragma unroll
                for (int kb = 0; kb < 5; ++kb)
#pragma unroll
                    for (int r = 0; r < 16; ++r) { const int kr = 32 * kb + crow(r, hh2); const int dist = 128 + r32 - kr; const bool ok = (dist >= 0) && (dist <= 128) && (mk0 + kr >= 0);
                        const float s = ok ? S[kb][r] : -INFINITY; S[kb][r] = s; mx = fmaxf(mx, s); }
                mx = fmaxf(mx, __shfl_xor(mx, 32));
                float lsum = 0.f;
#pragma unroll
                for (int kb = 0; kb < 5; ++kb)
#pragma unroll
                    for (int r = 0; r < 16; ++r) { const float p = __builtin_amdgcn_exp2f(S[kb][r] - mx); S[kb][r] = p; lsum += p; }
                lsum += __shfl_xor(lsum, 32);
                bf16x8 pf[5][2];
#pragma unroll
                for (int kb = 0; kb < 5; ++kb)
#pragma unroll
                    for (int s2 = 0; s2 < 2; ++s2) { u32x4 w; w.x = cvtpk(S[kb][8 * s2 + 0], S[kb][8 * s2 + 1]); w.y = cvtpk(S[kb][8 * s2 + 2], S[kb][8 * s2 + 3]); w.z = cvtpk(S[kb][8 * s2 + 4], S[kb][8 * s2 + 5]); w.w = cvtpk(S[kb][8 * s2 + 6], S[kb][8 * s2 + 7]);
                        pf[kb][s2] = __builtin_bit_cast(bf16x8, w); }
                __syncthreads();
                f32x16 O[4];
#pragma unroll
                for (int db = 0; db < 4; ++db) O[db] = (f32x16){};
                const LAS unsigned char* vb = VT + (32 * wave + 4 * hh2 + q4) * 320 + (16 * blk + 4 * p4) * 2;
#pragma unroll
                for (int kb = 0; kb < 5; ++kb)
#pragma unroll
                    for (int s2 = 0; s2 < 2; ++s2) { const LAS unsigned char* vk = vb + (32 * kb + 16 * s2) * 320;
#pragma unroll
                        for (int db = 0; db < 4; ++db) { const s16x4 l0 = vtr(vk + 64 * db), h0 = vtr(vk + 8 * 320 + 64 * db);
                            const bf16x8 a = {l0[0], l0[1], l0[2], l0[3], h0[0], h0[1], h0[2], h0[3]};
                            O[db] = MFMA32(a, pf[kb][s2], O[db]); } }
                const size_t tq = tbase + (size_t)mq * dl;
                bf16* orow = OPART + ((size_t)pat * NTOK + tq) * DG + head * 128 + 4 * hh2;
#pragma unroll
                for (int db = 0; db < 4; ++db)
#pragma unroll
                    for (int gq = 0; gq < 4; ++gq) { u32x2 o; o.x = cvtpk(O[db][4 * gq + 0], O[db][4 * gq + 1]); o.y = cvtpk(O[db][4 * gq + 2], O[db][4 * gq + 3]); *(u32x2*)(orow + 32 * db + 8 * gq) = o; }
                if (hh2 == 0) *(f32x2*)(ML + (((size_t)pat * NTOK + tq) * 8 + head) * 2) = (f32x2){mx, lsum};
                __syncthreads();
            }
        }
    }
    SEAM(4);

    if (IN(5)) {
        const int RPW = NTOK / NGW, row0 = gw * RPW, head = lane >> 3;
        float ga[16], gb[16];
#pragma unroll
        for (int i = 0; i < 16; ++i) { ga[i] = g_out_gmlp[16 * lane + i]; gb[i] = g_out_attn[16 * lane + i]; }
        for (int r = 0; r < RPW; ++r) {
            const size_t row = (size_t)(row0 + r);
            f32x2 ml[3]; float M = -INFINITY;
#pragma unroll
            for (int p = 0; p < 3; ++p) { ml[p] = *(const f32x2*)(ML + (((size_t)p * NTOK + row) * 8 + head) * 2); M = fmaxf(M, ml[p].x); }
            float o[16]; float den = 0.f;
#pragma unroll
            for (int i = 0; i < 16; ++i) o[i] = 0.f;
#pragma unroll
            for (int p = 0; p < 3; ++p) { const float w = __builtin_amdgcn_exp2f(ml[p].x - M); den += w * ml[p].y;
                const bf16* op = OPART + ((size_t)p * NTOK + row) * DG + 16 * lane; float f[8], f2[8]; unpack8(*(const u32x4*)op, f); unpack8(*(const u32x4*)(op + 8), f2);
#pragma unroll
                for (int i = 0; i < 8; ++i) { o[i] += w * f[i]; o[8 + i] += w * f2[i]; } }
            const float inv = 1.0f / den; float ss = 0.f;
#pragma unroll
            for (int i = 0; i < 16; ++i) { o[i] *= inv; ss += o[i] * o[i]; }
            const float rb = __builtin_amdgcn_rsqf(wave_sum(ss) * (1.0f / DG) + EPS);
            bf16* pr = PROJ + row * DIN + 16 * lane;
            { float f[8], f2[8];
#pragma unroll
              for (int i = 0; i < 8; ++i) { f[i] = o[i] * rb * gb[i]; f2[i] = o[8 + i] * rb * gb[8 + i]; }
              *(u32x4*)(pr + DG) = pack8(f); *(u32x4*)(pr + DG + 8) = pack8(f2); }
            { const float ra = __builtin_amdgcn_rsqf(YASS[row] * (1.0f / DG) + EPS); float f[8], f2[8]; unpack8(*(const u32x4*)pr, f); unpack8(*(const u32x4*)(pr + 8), f2);
#pragma unroll
              for (int i = 0; i < 8; ++i) { f[i] = f[i] * ra * ga[i]; f2[i] = f2[i] * ra * ga[8 + i]; }
              *(u32x4*)pr = pack8(f); *(u32x4*)(pr + 8) = pack8(f2); }
        }
    }
    SEAM(5);

    if (IN(6)) {
        pg8::Gemm g{PROJ, WOUT, DM, DIN, nullptr}; pg8::StaticOrder S; S.init(NTOK / 256, DM / 256, G, c);
        pg8::EpiPlain E{Y1, DM, 1.0f};
        pg8::gemm_phase<pg8::EpiPlain, pg8::StaticOrder, true, false>(lds, g, S, E);
    }
    SEAM(6);

    if (IN(7)) {
        const int TPW = NTOK / G, tok0 = c * TPW, b = tok0 / SEQ;
        LAS unsigned char* HI = lds; LAS unsigned char* LO = lds + 65536;
        LAS float* A1 = (LAS float*)(lds + 131072); LAS float* A2 = A1 + DM; LAS float* S2 = A2 + DM;
        LAS float* part = (LAS float*)lds;
        LAS float* logit = (LAS float*)(lds + XTRA_OFF);
        LAS int* hist = (LAS int*)(lds + MISC_OFF + 64);
        for (int i = tid; i < DM; i += 512) { A1[i] = MOD[b * NMOD + 2 * DM + i] * g_post_mix[i]; A2[i] = g_pre_ffn[i] * (1.0f + MOD[b * NMOD + 4 * DM + i]); S2[i] = MOD[b * NMOD + 3 * DM + i]; }
        if (tid < 32) hist[tid] = 0;
        __syncthreads();
        const int fr = lane & 15, fq = lane >> 4;
        u32x4 yq[2][4]; f32x4 xq[2][8];
#define P7_LOAD(ti_) do { _Pragma("unroll") for (int rr2 = 0; rr2 < 2; ++rr2) { const int tok_ = tok0 + 16 * (ti_) + 2 * wave + rr2; \
            const float* xr_ = x + (size_t)tok_ * DM + 8 * lane; const bf16* yr_ = Y1 + (size_t)tok_ * DM + 8 * lane; \
            _Pragma("unroll") for (int j = 0; j < 4; ++j) { yq[rr2][j] = *(const u32x4*)(yr_ + 512 * j); xq[rr2][2 * j] = *(const f32x4*)(xr_ + 512 * j); xq[rr2][2 * j + 1] = *(const f32x4*)(xr_ + 512 * j + 4); } } } while (0)
        P7_LOAD(0);
        for (int ti = 0; ti < TPW / 16; ++ti) {
#pragma unroll
            for (int rr2 = 0; rr2 < 2; ++rr2) {
                const int rr = 2 * wave + rr2, tok = tok0 + 16 * ti + rr;
                float* o1 = out + (size_t)tok * DM; unsigned char* hr = HB8 + (size_t)tok * DM;
                float xv[32], yv[32]; float ss = 0.f;
#pragma unroll
                for (int j = 0; j < 4; ++j) { float f[8]; unpack8(yq[rr2][j], f);
#pragma unroll
                    for (int i = 0; i < 8; ++i) { yv[8 * j + i] = f[i]; ss += f[i] * f[i]; } }
#pragma unroll
                for (int j = 0; j < 4; ++j) {
#pragma unroll
                    for (int i = 0; i < 4; ++i) { xv[8 * j + i] = xq[rr2][2 * j][i]; xv[8 * j + 4 + i] = xq[rr2][2 * j + 1][i]; } }
                const float r1 = __builtin_amdgcn_rsqf(wave_sum(ss) * (1.0f / DM) + EPS);
                float ss2 = 0.f;
#pragma unroll
                for (int j = 0; j < 4; ++j) { const f32x4 a0 = *(const LAS f32x4*)(A1 + 512 * j + 8 * lane), a1 = *(const LAS f32x4*)(A1 + 512 * j + 8 * lane + 4);
#pragma unroll
                    for (int i = 0; i < 4; ++i) { xv[8 * j + i] += a0[i] * yv[8 * j + i] * r1; xv[8 * j + 4 + i] += a1[i] * yv[8 * j + 4 + i] * r1; }
                    f32x4 oa, ob;
#pragma unroll
                    for (int i = 0; i < 4; ++i) { oa[i] = xv[8 * j + i]; ob[i] = xv[8 * j + 4 + i]; ss2 += oa[i] * oa[i] + ob[i] * ob[i]; }
                    *(f32x4*)(o1 + 512 * j + 8 * lane) = oa; *(f32x4*)(o1 + 512 * j + 8 * lane + 4) = ob; }
                const float r2 = __builtin_amdgcn_rsqf(wave_sum(ss2) * (1.0f / DM) + EPS);
#pragma unroll
                for (int j = 0; j < 4; ++j) { const f32x4 a0 = *(const LAS f32x4*)(A2 + 512 * j + 8 * lane), a1 = *(const LAS f32x4*)(A2 + 512 * j + 8 * lane + 4);
                    const f32x4 s0 = *(const LAS f32x4*)(S2 + 512 * j + 8 * lane), s1 = *(const LAS f32x4*)(S2 + 512 * j + 8 * lane + 4);
                    float f[8], fl[8];
#pragma unroll
                    for (int i = 0; i < 4; ++i) { f[i] = xv[8 * j + i] * r2 * a0[i] + s0[i]; f[4 + i] = xv[8 * j + 4 + i] * r2 * a1[i] + s1[i]; }
                    const u32x4 hw = pack8(f); float fh[8]; unpack8(hw, fh);
#pragma unroll
                    for (int i = 0; i < 8; ++i) fl[i] = f[i] - fh[i];
                    { u32x2 h8; h8.x = cvt4_fp8(f[0], f[1], f[2], f[3]); h8.y = cvt4_fp8(f[4], f[5], f[6], f[7]); *(u32x2*)(hr + 512 * j + 8 * lane) = h8; }
                    const int off = rr * 4096 + (((64 * j + lane) ^ rr) << 4);
                    *(LAS u32x4*)(HI + off) = hw; *(LAS u32x4*)(LO + off) = pack8(fl); }
            }
            __syncthreads();
            f32x4 acc[3] = {{0.f, 0.f, 0.f, 0.f}, {0.f, 0.f, 0.f, 0.f}, {0.f, 0.f, 0.f, 0.f}};
#pragma unroll 4
            for (int s8 = 0; s8 < 8; ++s8) { const int ks = 8 * wave + s8; const int off = fr * 4096 + (((4 * ks + fq) ^ fr) << 4);
                const bf16x8 ah = *(const LAS bf16x8*)(HI + off), al = *(const LAS bf16x8*)(LO + off);
                const bf16* wf = WRF + ((size_t)(ks * 6) * 64 + lane) * 8;
#pragma unroll
                for (int nt = 0; nt < 3; ++nt) { const bf16x8 bh = *(const bf16x8*)(wf + (size_t)(2 * nt) * 512), bl = *(const bf16x8*)(wf + (size_t)(2 * nt + 1) * 512);
                    acc[nt] = __builtin_amdgcn_mfma_f32_16x16x32_bf16(ah, bh, acc[nt], 0, 0, 0);
                    acc[nt] = __builtin_amdgcn_mfma_f32_16x16x32_bf16(al, bh, acc[nt], 0, 0, 0);
                    acc[nt] = __builtin_amdgcn_mfma_f32_16x16x32_bf16(ah, bl, acc[nt], 0, 0, 0); } }
            if (ti + 1 < TPW / 16) P7_LOAD(ti + 1);
            __syncthreads();
#pragma unroll
            for (int nt = 0; nt < 3; ++nt)
#pragma unroll
                for (int r = 0; r < 4; ++r) part[(wave * 16 + 4 * fq + r) * 48 + 16 * nt + fr] = acc[nt][r];
            __syncthreads();
            { const int tk = tid >> 5, j = tid & 31;
              float sa = 0.f, sb = 0.f;
#pragma unroll
              for (int w = 0; w < 8; ++w) { sa += part[(w * 16 + tk) * 48 + j]; if (j < 4) sb += part[(w * 16 + tk) * 48 + 32 + j]; }
              logit[tk * 36 + j] = sa; if (j < 4) logit[tk * 36 + 32 + j] = sb; }
            __syncthreads();
            if (tid < 16) {
                const int tok = tok0 + 16 * ti + tid; const LAS float* L = logit + tid * 36;
                float lg[4]; int gi = 0;
#pragma unroll
                for (int q = 0; q < 4; ++q) lg[q] = L[q] + b_rg[q];
                float gm = lg[0];
#pragma unroll
                for (int q = 1; q < 4; ++q) if (lg[q] > gm) { gm = lg[q]; gi = q; }
                float gden = 0.f;
#pragma unroll
                for (int q = 0; q < 4; ++q) gden += __expf(lg[q] - gm);
                const float gp = 1.0f / gden;
                float le[8];
#pragma unroll
                for (int q = 0; q < 8; ++q) le[q] = L[4 + 8 * gi + q] + b_re[gi * 8 + q];
                int i0 = 0; float m0 = le[0];
#pragma unroll
                for (int q = 1; q < 8; ++q) if (le[q] > m0) { m0 = le[q]; i0 = q; }
                int i1 = -1; float m1 = -INFINITY;
#pragma unroll
                for (int q = 0; q < 8; ++q) if (q != i0 && le[q] > m1) { m1 = le[q]; i1 = q; }
                const float e1 = __expf(m1 - m0), w0 = gp / (1.0f + e1), w1 = gp * e1 / (1.0f + e1);
                const int ea = gi * 8 + i0, eb = gi * 8 + i1;
                const int ra = __hip_atomic_fetch_add(hist + ea, 1, __ATOMIC_RELAXED, __HIP_MEMORY_SCOPE_WORKGROUP), rb = __hip_atomic_fetch_add(hist + eb, 1, __ATOMIC_RELAXED, __HIP_MEMORY_SCOPE_WORKGROUP);
                EID[2 * tok] = ea; EID[2 * tok + 1] = eb; LRANK[2 * tok] = ra; LRANK[2 * tok + 1] = rb; WT[2 * tok] = w0; WT[2 * tok + 1] = w1;
            }
        }
#undef P7_LOAD
        __syncthreads();
        if (tid < 32) LCNT[c * 32 + tid] = hist[tid];
    }
    SEAM(7);

    if (IN(8)) {
        build_tiles(LCNT, G, c, lds, true);
        const LAS int* base = (const LAS int*)(lds + MISC_OFF + 1536);
        const int TPW = NTOK / G, tok0 = c * TPW;
        for (int i = tid; i < 2 * TPW; i += 512) { const int idx = 2 * tok0 + i; const int e = EID[idx]; const int pos = base[e] + LRANK[idx]; ROWTOK[pos] = idx >> 1; TOKPOS[idx] = pos; }
    }
    SEAM(8);

    if (IN(9)) {
        build_tiles(LCNT, G, c, lds, false);
        const LAS int* ttab = (const LAS int*)(lds + MISC_OFF + 256);
        pg8::Gemm g{(const bf16*)HB8, (const bf16*)WGU, DM / 2, DM / 2, ROWTOK}; pg8::MoeOrder S; S.init(ttab[0], 8, G, c); S.tile_e = ttab + 1;
        pg8::EpiSwiglu8 E{ACT, DE};
        pg8::gemm_phase<pg8::EpiSwiglu8, pg8::MoeOrder, true, true, true>(lds, g, S, E);
    }
    SEAM(9);

    if (IN(10)) {
        build_tiles(LCNT, G, c, lds, false);
        const LAS int* ttab = (const LAS int*)(lds + MISC_OFF + 256);
        pg8::Gemm g{(const bf16*)ACT, (const bf16*)WDN, DE / 2, DE / 2, nullptr}; pg8::MoeOrder S; S.init(ttab[0], 8, G, c); S.tile_e = ttab + 1;
        pg8::EpiPlain E{YBUF, DM, 1.0f / 256.0f};
        pg8::gemm_phase<pg8::EpiPlain, pg8::MoeOrder, true, false, true>(lds, g, S, E);
    }
    SEAM(10);

    if (IN(11)) {
        const int RPW = NTOK / NGW, row0 = gw * RPW, b = row0 / SEQ;
        float av[32];
#pragma unroll
        for (int j = 0; j < 4; ++j)
#pragma unroll
            for (int i = 0; i < 8; ++i) { const int ch = 512 * j + 8 * lane + i; av[8 * j + i] = g_post_ffn[ch] * MOD[b * NMOD + 5 * DM + ch]; }
        for (int r = 0; r < RPW; ++r) {
            const int tok = row0 + r; const int p0 = TOKPOS[2 * tok], p1 = TOKPOS[2 * tok + 1]; const float w0 = WT[2 * tok], w1 = WT[2 * tok + 1];
            const bf16* ya = YBUF + (size_t)p0 * DM; const bf16* yb = YBUF + (size_t)p1 * DM; float* o1 = out + (size_t)tok * DM;
            float yv[32]; float ss = 0.f;
#pragma unroll
            for (int j = 0; j < 4; ++j) { float f[8], f2[8]; unpack8(*(const u32x4*)(ya + 512 * j + 8 * lane), f); unpack8(*(const u32x4*)(yb + 512 * j + 8 * lane), f2);
#pragma unroll
                for (int i = 0; i < 8; ++i) { const float v = w0 * f[i] + w1 * f2[i]; yv[8 * j + i] = v; ss += v * v; } }
            const float rs = __builtin_amdgcn_rsqf(wave_sum(ss) * (1.0f / DM) + EPS);
#pragma unroll
            for (int j = 0; j < 4; ++j) { f32x4 a = *(const f32x4*)(o1 + 512 * j + 8 * lane), bq = *(const f32x4*)(o1 + 512 * j + 8 * lane + 4);
#pragma unroll
                for (int i = 0; i < 4; ++i) { a[i] += av[8 * j + i] * yv[8 * j + i] * rs; bq[i] += av[8 * j + 4 + i] * yv[8 * j + 4 + i] * rs; }
                *(f32x4*)(o1 + 512 * j + 8 * lane) = a; *(f32x4*)(o1 + 512 * j + 8 * lane + 4) = bq; }
        }
    }
#undef IN
#undef SEAM
}

extern "C" void kernel_launch(void* const* d_in, const int* in_sizes, int n_in, void* d_out, int out_size, void* d_ws, size_t ws_size, hipStream_t stream) {
    static int grid = 0;
    if (grid == 0) {
        if (n_in != 22 || in_sizes[0] != NTOK * DM || out_size != NTOK * DM || ws_size < WS_END) { fprintf(stderr, "kernel_launch: unexpected shapes (n_in %d, in0 %d, out %d, ws %zu < %zu?)\n", n_in, n_in > 0 ? in_sizes[0] : -1, out_size, ws_size, (size_t)WS_END); grid = -1; return; }
        int dev = 0, cus = 0, per_cu = 0;
        if (hipGetDevice(&dev) != hipSuccess || hipDeviceGetAttribute(&cus, hipDeviceAttributeMultiprocessorCount, dev) != hipSuccess) { grid = -1; return; }
        if (hipFuncSetAttribute((const void*)fwd_kernel, hipFuncAttributeMaxDynamicSharedMemorySize, LDS_BYTES) != hipSuccess) { fprintf(stderr, "kernel_launch: hipFuncSetAttribute failed\n"); grid = -1; return; }
        if (hipOccupancyMaxActiveBlocksPerMultiprocessor(&per_cu, (const void*)fwd_kernel, NWAVES * 64, LDS_BYTES) != hipSuccess || per_cu < 1) { fprintf(stderr, "kernel_launch: occupancy query says %d\n", per_cu); }
        (void)hipGetLastError();
        grid = cus;
        if (grid != 256) fprintf(stderr, "kernel_launch: %d CUs; this kernel is laid out for 256\n", grid);
        if (NTOK % (grid * NWAVES) != 0) { fprintf(stderr, "kernel_launch: grid %d does not divide the token rows\n", grid); grid = -1; return; }
    }
    if (grid < 0) return;
    if (hipMemsetAsync((char*)d_ws + WS_CTL, 0, CTL_ZERO_BYTES, stream) != hipSuccess) return;
    Args a{};
    for (int i = 0; i < 22; ++i) a.in[i] = (const float*)d_in[i];
    a.out = (float*)d_out; a.ws = (unsigned char*)d_ws;
    if (MK_N_LAUNCHES == 1) { a.ph_lo = 0; a.ph_hi = NPHASE; hipLaunchKernelGGL(fwd_kernel, dim3(grid), dim3(NWAVES * 64), LDS_BYTES, stream, a); }
    else { static const int seq[] = {MK_SEQ}; for (int p : seq) { a.ph_lo = p; a.ph_hi = p + 1; hipLaunchKernelGGL(fwd_kernel, dim3(grid), dim3(NWAVES * 64), LDS_BYTES, stream, a); } }
}
```

```cpp
#include <hip/hip_runtime.h>
#include <cstdio>
#include <cstdint>

#ifndef MK_N_LAUNCHES
#define MK_N_LAUNCHES 1
#endif

#ifndef MK_SEQ
#define MK_SEQ 0, 1, 2, 3, 4, 5, 6, 7, 8, 9, 10, 11
#endif
#ifndef MK_AMP
#define MK_AMP 0, 0, 0, 0, 0, 0, 0, 0, 0, 0, 0, 0
#endif
#define LAS __attribute__((address_space(3)))
#define GAS __attribute__((address_space(1)))
typedef unsigned short bf16;
typedef short bf16x8 __attribute__((ext_vector_type(8)));
typedef short s16x4 __attribute__((ext_vector_type(4)));
typedef float f32x4 __attribute__((ext_vector_type(4)));
typedef float f32x2 __attribute__((ext_vector_type(2)));
typedef float f32x16 __attribute__((ext_vector_type(16)));
typedef unsigned u32x4 __attribute__((ext_vector_type(4)));
typedef unsigned u32x2 __attribute__((ext_vector_type(2)));
typedef __bf16 bf16x2_t __attribute__((ext_vector_type(2)));
typedef short v4i16_t __attribute__((ext_vector_type(4)));
typedef int v8i32_t __attribute__((ext_vector_type(8)));
typedef int v8i32_a16 __attribute__((ext_vector_type(8), aligned(16)));

constexpr int NB = 4, SEQ = 8192, NTOK = NB * SEQ, DM = 2048, DIN = 5120, DG = 1024, NE = 32, DE = 1024;
constexpr int NMOD = 6 * DM;
constexpr int PP = 2048;
constexpr float EPS = 1e-6f;
constexpr int PMAX = 73728;
constexpr int TMAX = PMAX / 256;
constexpr float QSCALE = 0.12751743f;

__device__ __forceinline__ unsigned cvtpk(float lo, float hi) { f32x2 v = {lo, hi}; bf16x2_t b = __builtin_convertvector(v, bf16x2_t); return __builtin_bit_cast(unsigned, b); }
__device__ __forceinline__ unsigned cvt4_fp8(float a, float b, float c, float d) { int w = 0; w = __builtin_amdgcn_cvt_pk_fp8_f32(a, b, w, false); w = __builtin_amdgcn_cvt_pk_fp8_f32(c, d, w, true); return (unsigned)w; }
__device__ __forceinline__ void unpack8_fp8(const u32x2 w, float (&f)[8]) { const f32x2 a = __builtin_amdgcn_cvt_pk_f32_fp8((int)w.x, false), b = __builtin_amdgcn_cvt_pk_f32_fp8((int)w.x, true), c = __builtin_amdgcn_cvt_pk_f32_fp8((int)w.y, false), d = __builtin_amdgcn_cvt_pk_f32_fp8((int)w.y, true);
    f[0] = a[0]; f[1] = a[1]; f[2] = b[0]; f[3] = b[1]; f[4] = c[0]; f[5] = c[1]; f[6] = d[0]; f[7] = d[1]; }
__device__ __forceinline__ float bflo(unsigned w) { return __uint_as_float(w << 16); }
__device__ __forceinline__ float bfhi(unsigned w) { return __uint_as_float(w & 0xffff0000u); }
__device__ __forceinline__ float wave_sum(float v) {
#pragma unroll
    for (int o = 1; o < 64; o <<= 1) v += __shfl_xor(v, o);
    return v;
}
__device__ __forceinline__ float gelu_t(float v) { const float a = v * __builtin_fmaf(-0.10294324f, v * v, -2.302208198f); const float e = __builtin_amdgcn_exp2f(a); return v * __builtin_amdgcn_rcpf(1.0f + e); }
__device__ __forceinline__ float silu_f(float v) { return v * __builtin_amdgcn_rcpf(1.0f + __builtin_amdgcn_exp2f(-1.442695041f * v)); }

namespace pg8 {
constexpr int BM = 256, BK = 64, HALF = 128, HTB = HALF * BK * 2, STAGE_BYTES = 8 * HTB, NXCD = 8, WGM = 8;
__host__ __device__ __forceinline__ int lds_byte(int r, int c) { const int st = (r >> 4) * 2 + (c >> 5), rr = r & 15, cc = c & 31, ob = rr * 64 + cc * 2; return st * 1024 + (ob ^ (((ob >> 9) & 1) << 5)); }
__host__ __device__ __forceinline__ void stage_rc(int b, int& R, int& C) { const int st = b / 1024, sb = b % 1024, swz = sb ^ (((sb >> 9) & 1) << 5); R = (st >> 1) * 16 + swz / 64; C = (st & 1) * 32 + (swz % 64) / 2; }
__host__ __device__ __forceinline__ int perm32(int rho) { const int n = rho >> 4, i = rho & 15; return 8 * (i >> 2) + 4 * n + (i & 3); }

struct Unit { int pm, pn; };
struct Gemm { const bf16* A; const bf16* Bt; int K; int lda; const int* arow; int sexp; const float* rss; };

struct StaticOrder {
    int nM, nN, nwg, G, c;
    __device__ void init(int nM_, int nN_, int G_, int c_) { nM = nM_; nN = nN_; nwg = nM * nN; G = G_; c = c_; }
    __device__ bool next(int i, Unit& u) const {
        const long L = (long)i * G + c; if (L >= nwg) return false;
        int wgid = (int)L; { const int q = nwg / NXCD, r = nwg % NXCD, xcd = wgid % NXCD, off = wgid / NXCD; wgid = (xcd < r ? xcd * (q + 1) : r * (q + 1) + (xcd - r) * q) + off; }
        const int nig = WGM * nN, gid = wgid / nig, fm = gid * WGM, gsz = (nM - fm) < WGM ? (nM - fm) : WGM;
        u.pm = fm + ((wgid % nig) % gsz); u.pn = (wgid % nig) / gsz; return true;
    }
    __device__ __forceinline__ int bidx(const Unit& u) const { return u.pn; }
    __device__ __forceinline__ int aoff(int pm) const { return pm * BM; }
};
struct MoeOrder : StaticOrder {
    const LAS int* tile_e; const LAS int* tile_l;
    __device__ __forceinline__ int bidx(const Unit& u) const { return tile_e[u.pm] * nN + u.pn; }
    __device__ __forceinline__ int aoff(int pm) const { return tile_l[pm]; }
};

struct EpiInProj {
    static constexpr bool PERM = true;
    bf16* O; int ldc; bf16* QKV; float* VST;
    __device__ __forceinline__ void operator()(const f32x4 (&acc)[2][2][4][2], const Unit& u, int wr, int wc, int fr, int fq) const {
        const int row0 = u.pm * BM + wr * 64 + fr;
        if (u.pn < 8) {
            const int col0 = u.pn * BM + wc * 32 + 8 * fq;
#pragma unroll
            for (int ai = 0; ai < 2; ++ai)
#pragma unroll
                for (int m = 0; m < 4; ++m) { bf16* rowp = O + (size_t)(row0 + ai * HALF + m * 16) * ldc + col0; float s1 = 0.f, s2 = 0.f;
#pragma unroll
                    for (int bj = 0; bj < 2; ++bj) { f32x4 v0 = acc[ai][bj][m][0], v1 = acc[ai][bj][m][1];
#pragma unroll
                        for (int j = 0; j < 4; ++j) { v0[j] = gelu_t(v0[j]); v1[j] = gelu_t(v1[j]); }
                        u32x4 w; w.x = cvtpk(v0[0], v0[1]); w.y = cvtpk(v0[2], v0[3]); w.z = cvtpk(v1[0], v1[1]); w.w = cvtpk(v1[2], v1[3]);
                        *(u32x4*)(rowp + bj * HALF) = w;
                        if (u.pn >= 4) {
#pragma unroll
                            for (int j = 0; j < 4; ++j) { s1 += v0[j] + v1[j]; s2 += v0[j] * v0[j] + v1[j] * v1[j]; } } }
                    if (u.pn >= 4) { s1 += __shfl_xor(s1, 16); s2 += __shfl_xor(s2, 16); s1 += __shfl_xor(s1, 32); s2 += __shfl_xor(s2, 32);
                        if (fq == 0) *(f32x2*)(VST + ((size_t)(row0 + ai * HALF + m * 16) * 16 + (u.pn - 4) * 4 + wc) * 2) = (f32x2){s1, s2}; } }
        } else {
            const int which = (u.pn - 8) >> 2, hp = (u.pn - 8) & 3; const float sc = which == 0 ? QSCALE : 1.0f;
            bf16* base = QKV + (size_t)which * NTOK * 1024 + wc * 32 + 8 * fq;
#pragma unroll
            for (int ai = 0; ai < 2; ++ai)
#pragma unroll
                for (int m = 0; m < 4; ++m) { const int r = row0 + ai * HALF + m * 16, bb = r >> 13, sq = r & (SEQ - 1);
#pragma unroll
                    for (int bj = 0; bj < 2; ++bj) { const f32x4 v0 = acc[ai][bj][m][0] * sc, v1 = acc[ai][bj][m][1] * sc;
                        u32x4 w; w.x = cvtpk(v0[0], v0[1]); w.y = cvtpk(v0[2], v0[3]); w.z = cvtpk(v1[0], v1[1]); w.w = cvtpk(v1[2], v1[3]);
                        *(u32x4*)(base + ((size_t)(bb * 8 + 2 * hp + bj) * SEQ + sq) * 128) = w; } }
        }
    }
};
struct EpiPlain8 {
    static constexpr bool PERM = true;
    unsigned char* O; int ldc;
    __device__ __forceinline__ void operator()(const f32x4 (&acc)[2][2][4][2], const Unit& u, int wr, int wc, int fr, int fq) const {
        const int row0 = u.pm * BM + wr * 64 + fr + 16 * (fq & 1), col0 = u.pn * BM + wc * 32 + 8 * (fq & 2);
#pragma unroll
        for (int ai = 0; ai < 2; ++ai)
#pragma unroll
            for (int mp = 0; mp < 2; ++mp) { unsigned char* rowp = O + (size_t)(row0 + ai * HALF + mp * 32) * ldc + col0;
#pragma unroll
                for (int bj = 0; bj < 2; ++bj) { const f32x4 a0 = acc[ai][bj][2 * mp][0], a1 = acc[ai][bj][2 * mp][1], b0 = acc[ai][bj][2 * mp + 1][0], b1 = acc[ai][bj][2 * mp + 1][1];
                    const u32x2 sx = __builtin_amdgcn_permlane16_swap(cvt4_fp8(a0[0], a0[1], a0[2], a0[3]), cvt4_fp8(b0[0], b0[1], b0[2], b0[3]), false, false);
                    const u32x2 sy = __builtin_amdgcn_permlane16_swap(cvt4_fp8(a1[0], a1[1], a1[2], a1[3]), cvt4_fp8(b1[0], b1[1], b1[2], b1[3]), false, false);
                    *(u32x4*)(rowp + bj * HALF) = (u32x4){sx[0], sy[0], sx[1], sy[1]}; } }
    }
};
struct EpiSwiglu8 {
    static constexpr bool PERM = true;
    unsigned char* O; int ldc;
    __device__ __forceinline__ void operator()(const f32x4 (&acc)[2][2][4][2], const Unit& u, int wr, int wc, int fr, int fq) const {
        const int row0 = u.pm * BM + wr * 64 + fr, col0 = u.pn * HALF + wc * 32 + 8 * fq;
#pragma unroll
        for (int ai = 0; ai < 2; ++ai)
#pragma unroll
            for (int m = 0; m < 4; ++m) { unsigned char* rowp = O + (size_t)(row0 + ai * HALF + m * 16) * ldc + col0;
                f32x4 v0, v1;
#pragma unroll
                for (int j = 0; j < 4; ++j) { v0[j] = silu_f(acc[ai][0][m][0][j]) * acc[ai][1][m][0][j] * 4.0f; v1[j] = silu_f(acc[ai][0][m][1][j]) * acc[ai][1][m][1][j] * 4.0f; }
                u32x2 w; w.x = cvt4_fp8(v0[0], v0[1], v0[2], v0[3]); w.y = cvt4_fp8(v1[0], v1[1], v1[2], v1[3]);
                *(u32x2*)rowp = w; }
    }
};
template <bool FP8> struct Frag { bf16x8 v[2]; };
template <> struct Frag<true> { v8i32_t v; };
template <class Epi, class Sched, bool ALIGN_EPI, bool GATHER, bool FP8 = false, int MIDK = 0>
__device__ __forceinline__ void gemm_phase(LAS unsigned char* lds, const Gemm g, const Sched& S, const Epi& E) {
    const int tid = threadIdx.x, wid = __builtin_amdgcn_readfirstlane(tid >> 6), lane = tid & 63, wr = wid >> 2, wc = wid & 3, fr = lane & 15, fq = lane >> 4;
    const int K = g.K, nt = K / BK, lda = g.lda;
    unsigned voffB[2]; int RA[2], CA[2];
    unsigned oc[2][2], on[2][2];
#pragma unroll
    for (int i = 0; i < 2; ++i) { int R, C; stage_rc(tid * 16 + i * 8192, R, C); const int Rb = Epi::PERM ? ((R & ~31) + perm32(R & 31)) : R;
        RA[i] = R; CA[i] = C; voffB[i] = (unsigned)(Rb * K + C) * 2u; }
    const size_t kstep = (size_t)(BK * 2);
    const size_t hstepB = (size_t)HALF * K * 2, tstepB = 2 * hstepB;
    const size_t tstepA = (size_t)BM * lda * 2;
    const unsigned ldsw = (unsigned)wid * 1024u;
    const int aoff = lds_byte(wr * 64 + fr, fq * 8), boff = lds_byte(wc * 32 + fr, fq * 8);
#define PG8_SA(b, h) (((b) * 2 + (h)) * HTB)
#define PG8_SB(b, h) ((4 + (b) * 2 + (h)) * HTB)
#define PG8_STAGE(bufoff, gbase, voff) do { _Pragma("unroll") for (int _i = 0; _i < 2; ++_i) \
        __builtin_amdgcn_global_load_lds((const unsigned*)((const char*)(gbase) + (voff)[_i]), (LAS unsigned*)(lds + (bufoff) + ldsw + _i * 8192), 16, 0, 0); } while (0)
#define PG8_LDA(dst, b, h) do { _Pragma("unroll") for (int m = 0; m < 4; ++m) { \
        if constexpr (FP8) dst[m].v = __builtin_bit_cast(v8i32_t, __builtin_shufflevector(*(const LAS bf16x8*)(lds + PG8_SA(b, h) + aoff + m * 2048), *(const LAS bf16x8*)(lds + PG8_SA(b, h) + aoff + m * 2048 + 1024), 0, 1, 2, 3, 4, 5, 6, 7, 8, 9, 10, 11, 12, 13, 14, 15)); \
        else { _Pragma("unroll") for (int k = 0; k < 2; ++k) dst[m].v[k] = *(const LAS bf16x8*)(lds + PG8_SA(b, h) + aoff + m * 2048 + k * 1024); } } } while (0)
#define PG8_LDB(dst, b, h) do { _Pragma("unroll") for (int n = 0; n < 2; ++n) { \
        if constexpr (FP8) dst[n].v = __builtin_bit_cast(v8i32_t, __builtin_shufflevector(*(const LAS bf16x8*)(lds + PG8_SB(b, h) + boff + n * 2048), *(const LAS bf16x8*)(lds + PG8_SB(b, h) + boff + n * 2048 + 1024), 0, 1, 2, 3, 4, 5, 6, 7, 8, 9, 10, 11, 12, 13, 14, 15)); \
        else { _Pragma("unroll") for (int k = 0; k < 2; ++k) dst[n].v[k] = *(const LAS bf16x8*)(lds + PG8_SB(b, h) + boff + n * 2048 + k * 1024); } } } while (0)
#define PG8_MMA(ai, bj, At, Bt) do { __builtin_amdgcn_s_setprio(1); _Pragma("unroll") for (int m = 0; m < 4; ++m) _Pragma("unroll") for (int n = 0; n < 2; ++n) { \
        if constexpr (FP8) asm volatile("v_mfma_scale_f32_16x16x128_f8f6f4 %0, %1, %2, %0, %3, %4 op_sel_hi:[0,0,0]" : "+v"(acc[ai][bj][m][n]) : "v"(Bt[n].v), "v"(At[m].v), "v"(sc1), "v"(sc2));   \
        else { _Pragma("unroll") for (int k = 0; k < 2; ++k) acc[ai][bj][m][n] = __builtin_amdgcn_mfma_f32_16x16x32_bf16(Bt[n].v[k], At[m].v[k], acc[ai][bj][m][n], 0, 0, 0); } } \
        __builtin_amdgcn_s_setprio(0); } while (0)
#define PG8_WAIT_V(n) asm volatile("s_waitcnt vmcnt(" #n ")" ::: "memory")
#define PG8_WAIT_L(n) asm volatile("s_waitcnt lgkmcnt(" #n ")" ::: "memory")
#define PG8_BAR __builtin_amdgcn_s_barrier()
#define PG8_SCHED __builtin_amdgcn_sched_barrier(0)
#define PG8_AOFF(dst, pm_) do { _Pragma("unroll") for (int _h = 0; _h < 2; ++_h) _Pragma("unroll") for (int _i = 0; _i < 2; ++_i) { \
        if constexpr (GATHER) { unsigned r_ = (unsigned)g.arow[S.aoff(pm_) + _h * HALF + RA[_i]]; r_ = r_ < (unsigned)NTOK ? r_ : 0u;     \
            dst[_h][_i] = (r_ * (unsigned)lda + (unsigned)CA[_i]) * 2u; } \
        else dst[_h][_i] = ((unsigned)(_h * HALF + RA[_i]) * (unsigned)lda + (unsigned)CA[_i]) * 2u; } } while (0)
    Unit cur, nxt; int ui = 0;
    if (!S.next(0, cur)) return;
    f32x4 acc[2][2][4][2];
#pragma unroll
    for (int a = 0; a < 2; ++a)
#pragma unroll
        for (int b = 0; b < 2; ++b)
#pragma unroll
            for (int m = 0; m < 4; ++m)
#pragma unroll
                for (int n = 0; n < 2; ++n) acc[a][b][m][n] = (f32x4){0.f, 0.f, 0.f, 0.f};
    Frag<FP8> At[4], B0[2], B1[2];
    LAS float* rtab = (LAS float*)(lds + STAGE_BYTES);
    float rnext = 0.f;
    const int sc1 = 0x7f7f7f7f, sc2 = 0x01010101 * (127 + g.sexp);
    PG8_AOFF(oc, cur.pm);
    if constexpr (MIDK != 0) { if (tid < BM) rtab[tid] = __builtin_amdgcn_rsqf(g.rss[cur.pm * BM + tid] * (1.0f / 1024.0f) + EPS); }
    const char* cA = (const char*)g.A + (GATHER ? (size_t)0 : (size_t)cur.pm * tstepA); const char* cB = (const char*)g.Bt + (size_t)S.bidx(cur) * tstepB;
    PG8_STAGE(PG8_SB(0, 0), cB, voffB); PG8_STAGE(PG8_SB(0, 1), cB + hstepB, voffB); PG8_STAGE(PG8_SA(0, 0), cA, oc[0]); PG8_STAGE(PG8_SA(0, 1), cA, oc[1]);
    if (wr == 1) PG8_BAR;
    PG8_WAIT_V(2); PG8_BAR;
    PG8_STAGE(PG8_SB(1, 0), cB + kstep, voffB); PG8_STAGE(PG8_SA(1, 0), cA + kstep, oc[0]); PG8_STAGE(PG8_SB(1, 1), cB + hstepB + kstep, voffB);
    PG8_WAIT_V(6); PG8_BAR;
    for (;;) {
        const bool has_next = S.next(ui + 1, nxt);
        const char* nA = cA; const char* nB = cB;
        if (has_next) { nA = (const char*)g.A + (GATHER ? (size_t)0 : (size_t)nxt.pm * tstepA); nB = (const char*)g.Bt + (size_t)S.bidx(nxt) * tstepB; PG8_AOFF(on, nxt.pm);
            if constexpr (MIDK != 0) { if (tid < BM) rnext = g.rss[nxt.pm * BM + tid]; } }
        else {
#pragma unroll
            for (int h = 0; h < 2; ++h)
#pragma unroll
                for (int i = 0; i < 2; ++i) on[h][i] = oc[h][i]; }
        for (int t = 0; t < nt; t += 2) {
            const bool last = (t == nt - 2);
            const char* a1 = cA + (size_t)(t + 1) * kstep;
            const char* a2 = last ? nA : cA + (size_t)(t + 2) * kstep; const char* b2 = last ? nB : cB + (size_t)(t + 2) * kstep;
            const char* a3 = a2 + kstep; const char* b3 = b2 + kstep;
            unsigned o2[2][2];
#pragma unroll
            for (int h = 0; h < 2; ++h)
#pragma unroll
                for (int i = 0; i < 2; ++i) o2[h][i] = last ? on[h][i] : oc[h][i];
            PG8_LDB(B0, 0, 0); PG8_LDB(B1, 0, 1); PG8_SCHED; PG8_LDA(At, 0, 0); PG8_STAGE(PG8_SA(1, 1), a1, oc[1]);
            if (t == 0 && ui > 0) {
#pragma unroll
                for (int a = 0; a < 2; ++a)
#pragma unroll
                    for (int b = 0; b < 2; ++b)
#pragma unroll
                        for (int m = 0; m < 4; ++m)
#pragma unroll
                            for (int n = 0; n < 2; ++n) acc[a][b][m][n] = (f32x4){0.f, 0.f, 0.f, 0.f};
            }
            if constexpr (MIDK != 0) { if (t == MIDK) {
#pragma unroll
                for (int a = 0; a < 2; ++a)
#pragma unroll
                    for (int b = 0; b < 2; ++b)
#pragma unroll
                        for (int m = 0; m < 4; ++m)
#pragma unroll
                            for (int n = 0; n < 2; ++n) acc[a][b][m][n] *= rtab[a * HALF + wr * 64 + m * 16 + fr];
            } }
            PG8_WAIT_V(8); PG8_WAIT_L(0); PG8_BAR; PG8_MMA(0, 0, At, B0); PG8_MMA(0, 1, At, B1); PG8_BAR; PG8_SCHED;
            PG8_LDA(At, 0, 1); PG8_STAGE(PG8_SB(0, 0), b2, voffB); PG8_STAGE(PG8_SB(0, 1), b2 + hstepB, voffB); PG8_STAGE(PG8_SA(0, 0), a2, o2[0]);
            PG8_WAIT_V(8); PG8_WAIT_L(0); PG8_BAR; PG8_MMA(1, 0, At, B0); PG8_MMA(1, 1, At, B1); PG8_BAR; PG8_SCHED;
            PG8_LDB(B0, 1, 0); PG8_LDB(B1, 1, 1); PG8_SCHED; PG8_LDA(At, 1, 0); PG8_STAGE(PG8_SA(0, 1), a2, o2[1]);
            PG8_WAIT_V(8); PG8_WAIT_L(0); PG8_BAR; PG8_MMA(0, 0, At, B0); PG8_MMA(0, 1, At, B1); PG8_BAR; PG8_SCHED;
            PG8_LDA(At, 1, 1); PG8_STAGE(PG8_SB(1, 0), b3, voffB); PG8_STAGE(PG8_SB(1, 1), b3 + hstepB, voffB); PG8_STAGE(PG8_SA(1, 0), a3, o2[0]);
            PG8_WAIT_V(8); PG8_WAIT_L(0); PG8_BAR; PG8_MMA(1, 0, At, B0); PG8_MMA(1, 1, At, B1); PG8_BAR; PG8_SCHED;
        }
        if constexpr (FP8) asm volatile("s_nop 15\n\ts_nop 15" ::: "memory");
        if constexpr (ALIGN_EPI) { if (wr == 0) PG8_BAR; }
        E(acc, cur, wr, wc, fr, fq);
        if (!has_next) break;
        cur = nxt; cA = nA; cB = nB; ++ui;
        if constexpr (MIDK != 0) { if (tid < BM) rtab[tid] = __builtin_amdgcn_rsqf(rnext * (1.0f / 1024.0f) + EPS); }
#pragma unroll
        for (int h = 0; h < 2; ++h)
#pragma unroll
            for (int i = 0; i < 2; ++i) oc[h][i] = on[h][i];
        if constexpr (ALIGN_EPI) { if (wr == 1) PG8_BAR; }
    }
    PG8_WAIT_V(0);
    if constexpr (!ALIGN_EPI) { if (wr == 0) PG8_BAR; }
    PG8_BAR;
#undef PG8_SA
#undef PG8_SB
#undef PG8_STAGE
#undef PG8_LDA
#undef PG8_LDB
#undef PG8_MMA
#undef PG8_WAIT_V
#undef PG8_WAIT_L
#undef PG8_BAR
#undef PG8_SCHED
#undef PG8_AOFF
}
}

constexpr size_t MiB = 1u << 20;
constexpr size_t WS_CTL = 0, CTL_ZERO_BYTES = 65536;
constexpr size_t WS_ROWTOK = 65536;
constexpr size_t WS_MOD = 1 * MiB;
constexpr size_t WS_WSM = 1 * MiB + 256 * 1024;
constexpr size_t WS_YASS = 1 * MiB + 512 * 1024;
constexpr size_t WS_EID = 1 * MiB + 768 * 1024;
constexpr size_t WS_LRANK = 2 * MiB;
constexpr size_t WS_WT = 2 * MiB + 256 * 1024;
constexpr size_t WS_TOKPOS = 2 * MiB + 512 * 1024;
constexpr size_t WS_LCNT = 2 * MiB + 768 * 1024;
constexpr size_t WS_LIST = 600 * MiB; constexpr int LCAP = 65536;
constexpr int CW_MODC = 8256;
constexpr int CW_ECNT = 8192;
constexpr size_t WS_ML = 3 * MiB;
constexpr size_t WS_WRF = 9 * MiB;
constexpr size_t WS_WIN = 10 * MiB;
constexpr size_t WS_WOUT = 30 * MiB;
constexpr size_t WS_WGU = 38 * MiB;
constexpr size_t WS_WDN = 166 * MiB;
constexpr size_t WS_HB = 230 * MiB;
constexpr size_t WS_PROJ = 358 * MiB;
constexpr size_t WS_QKV = 486 * MiB;
constexpr size_t WS_OPART = 678 * MiB;
constexpr size_t WS_Y1 = 870 * MiB;
constexpr size_t WS_ACT = 358 * MiB;
constexpr size_t WS_YBUF = 430 * MiB;
constexpr size_t WS_END = 998 * MiB;
static_assert(WS_ACT + (size_t)PMAX * DE <= WS_YBUF && WS_YBUF + (size_t)PMAX * DM <= WS_Y1 && WS_OPART + (size_t)3 * NTOK * 1024 * 2 <= WS_Y1 && WS_WDN + (size_t)NE * DM * DE <= WS_HB, "d_ws map");
constexpr int CW_BAR = 4096, XCD_BAR_WORDS_C = 3456;
static_assert((size_t)(CW_MODC + 64) * 4 <= CTL_ZERO_BYTES && (size_t)(CW_BAR + XCD_BAR_WORDS_C) * 4 <= (size_t)CW_ECNT * 4, "control words inside the memset region");

constexpr int RING_BYTES = 155648;
constexpr int MISC_OFF = RING_BYTES;
constexpr int XTRA_OFF = MISC_OFF + 2048;
constexpr int LDS_BYTES = 163840;
constexpr int NWAVES = 8;
constexpr int NPHASE = 12;
constexpr int kAmp[NPHASE] = {MK_AMP};
constexpr bool kAnyAmp = (kAmp[0] | kAmp[1] | kAmp[2] | kAmp[3] | kAmp[4] | kAmp[5] | kAmp[6] | kAmp[7] | kAmp[8] | kAmp[9] | kAmp[10] | kAmp[11]) != 0;

#define RLX_AGENT __ATOMIC_RELAXED, __HIP_MEMORY_SCOPE_AGENT
#define XB_TMO      128
#define XB_XCNT(j)  (256  + 64 * (j))
#define XB_XSUB(j)  (1280 + 64 * (j))
#define XB_XGEN(j)  (2304 + 64 * (j))
#define XB_TOP      3328
#define XB_TOPGEN   3392
#define XCD_BAR_WORDS 3456
#define XB_SPIN_CAP (1u << 18)
__device__ __forceinline__ unsigned xb_ld(unsigned* p)              { return __hip_atomic_load(p, __ATOMIC_RELAXED, __HIP_MEMORY_SCOPE_AGENT); }
__device__ __forceinline__ unsigned xb_add(unsigned* p, unsigned v) { return __hip_atomic_fetch_add(p, v, __ATOMIC_RELAXED, __HIP_MEMORY_SCOPE_AGENT); }
__device__ __forceinline__ unsigned xb_xcc_id() { return (unsigned)__builtin_amdgcn_s_getreg((3 << 11) | 20) & 0xFu; }
#define XB_SPIN(cond, bar) do { unsigned _sp = 0; while (cond) { __builtin_amdgcn_s_sleep(1); \
    if ((++_sp & 255u) == 0u) { if (xb_ld(&(bar)[XB_TMO])) break; if (_sp > XB_SPIN_CAP) { atomicAdd(&(bar)[XB_TMO], 1u); break; } } } } while (0)
struct XcdBarrier { unsigned* bar; unsigned x; volatile LAS unsigned* st; };
__device__ __forceinline__ XcdBarrier xcd_barrier_post(unsigned* bar, volatile LAS unsigned* st) {
    XcdBarrier b; b.bar = bar; b.x = xb_xcc_id(); b.st = st;
    if (threadIdx.x == 0) (void)xb_add(&bar[XB_XCNT(b.x)], 1u);
    return b;
}
__device__ __forceinline__ void xcd_barrier_complete(unsigned* bar, unsigned x, unsigned& nloc, unsigned& nx) {
    const unsigned G = gridDim.x * gridDim.y * gridDim.z;
    unsigned sum, cnt, mine, sp = 0u;
    for (;;) {
        sum = 0u; cnt = 0u; mine = 0u;
#pragma unroll
        for (unsigned j = 0; j < 16; ++j) { const unsigned c = xb_ld(&bar[XB_XCNT(j)]); sum += c; cnt += (c > 0u) ? 1u : 0u; mine = (j == x) ? c : mine; }
        if (sum == G) break;
        __builtin_amdgcn_s_sleep(1);
        if ((++sp & 255u) == 0u) { if (xb_ld(&bar[XB_TMO])) break; if (sp > XB_SPIN_CAP) { atomicAdd(&bar[XB_TMO], 1u); break; } }
    }
    nloc = mine > 0u ? mine : 1u; nx = cnt > 0u ? cnt : 1u;
}
__device__ __forceinline__ void xcd_barrier(const XcdBarrier& b) {
    asm volatile("s_waitcnt vmcnt(0)" ::: "memory");
    __syncthreads();
    if (threadIdx.x == 0) {
        unsigned* bar = b.bar;
        __builtin_amdgcn_s_waitcnt(0);
        unsigned nloc = b.st[0], nx = b.st[1];
        if (nloc == 0u) { xcd_barrier_complete(bar, b.x, nloc, nx); b.st[0] = nloc; b.st[1] = nx; }
        const unsigned old = xb_add(&bar[XB_XSUB(b.x)], 1u);
        const unsigned gen = old / nloc;
        if (old + 1u == (gen + 1u) * nloc) {
            __builtin_amdgcn_fence(__ATOMIC_RELEASE, "agent");
            asm volatile("s_waitcnt vmcnt(0)" ::: "memory");
            const unsigned og = xb_add(&bar[XB_TOP], 1u);
            const unsigned tg = og / nx;
            if (og + 1u == (tg + 1u) * nx) xb_add(&bar[XB_TOPGEN], 1u);
            else XB_SPIN(xb_ld(&bar[XB_TOPGEN]) == tg, bar);
            __builtin_amdgcn_fence(__ATOMIC_ACQUIRE, "agent");
            xb_add(&bar[XB_XGEN(b.x)], 1u);
            asm volatile("s_waitcnt vmcnt(0)" ::: "memory");
        } else {
            XB_SPIN(xb_ld(&bar[XB_XGEN(b.x)]) == gen, bar);
            __builtin_amdgcn_fence(__ATOMIC_ACQUIRE, "agent");
            asm volatile("s_waitcnt vmcnt(0)" ::: "memory");
        }
    }
    __syncthreads();
}

__device__ __forceinline__ s16x4 vtr(const LAS unsigned char* p) { return __builtin_bit_cast(s16x4, __builtin_amdgcn_ds_read_tr16_b64_v4i16((LAS v4i16_t*)p)); }
#define MFMA32(a, b, c) __builtin_amdgcn_mfma_f32_32x32x16_bf16((a), (b), (c), 0, 0, 0)
__device__ __forceinline__ int crow(int r, int hi) { return (r & 3) + 8 * (r >> 2) + 4 * hi; }
__device__ __forceinline__ void unpack8(const u32x4 w, float (&f)[8]) { f[0] = bflo(w.x); f[1] = bfhi(w.x); f[2] = bflo(w.y); f[3] = bfhi(w.y); f[4] = bflo(w.z); f[5] = bfhi(w.z); f[6] = bflo(w.w); f[7] = bfhi(w.w); }
__device__ __forceinline__ u32x4 pack8(const float (&f)[8]) { u32x4 w; w.x = cvtpk(f[0], f[1]); w.y = cvtpk(f[2], f[3]); w.z = cvtpk(f[4], f[5]); w.w = cvtpk(f[6], f[7]); return w; }

struct Args { const float* in[22]; float* out; unsigned char* ws; int ph_lo, ph_hi; };

__device__ __forceinline__ void transpose_item8(const float* W, int N, int k0, int n0, unsigned char* dst, int ldk, LAS float* scr, int lane) {
    const int cl = lane & 7, kq = lane >> 3;
#pragma unroll 4
    for (int i = 0; i < 16; ++i) { const int kk = 8 * i + kq; const f32x4 v = __builtin_nontemporal_load((const f32x4*)(W + (size_t)(k0 + kk) * N + n0 + 4 * cl));
        LAS float* s = scr + kk * 33 + 4 * cl; s[0] = v[0]; s[1] = v[1]; s[2] = v[2]; s[3] = v[3]; }
    asm volatile("s_waitcnt lgkmcnt(0)" ::: "memory");
    const int c = lane >> 4, nn = lane & 15;
#pragma unroll
    for (int it = 0; it < 2; ++it)
#pragma unroll
        for (int hh = 0; hh < 2; ++hh) { const int n = nn + 16 * it, kc = 16 * (c + 4 * hh); const LAS float* s = scr + kc * 33 + n; u32x4 o;
            o.x = cvt4_fp8(64.f * s[0], 64.f * s[33], 64.f * s[2 * 33], 64.f * s[3 * 33]); o.y = cvt4_fp8(64.f * s[4 * 33], 64.f * s[5 * 33], 64.f * s[6 * 33], 64.f * s[7 * 33]);
            o.z = cvt4_fp8(64.f * s[8 * 33], 64.f * s[9 * 33], 64.f * s[10 * 33], 64.f * s[11 * 33]); o.w = cvt4_fp8(64.f * s[12 * 33], 64.f * s[13 * 33], 64.f * s[14 * 33], 64.f * s[15 * 33]);
            __builtin_nontemporal_store(o, (u32x4*)(dst + (size_t)n * ldk + k0 + kc)); }
    asm volatile("s_waitcnt lgkmcnt(0)" ::: "memory");
}

__device__ __forceinline__ void build_tiles(const int* lcnt, int G, int c, LAS unsigned char* lds, bool want_base) {
    LAS int* tot = (LAS int*)(lds + MISC_OFF + 1792); LAS int* wof = tot + 32;
    LAS int* ttab = (LAS int*)(lds + MISC_OFF + 256); LAS int* base = (LAS int*)(lds + MISC_OFF + 1536);
    const int tid = threadIdx.x;
    LAS int* ptot = (LAS int*)lds; LAS int* pbef = ptot + 512;
    { const int e = tid & 31, sl = tid >> 5; int t = 0, b = 0;
      for (int w = sl; w < G; w += 16) { const int v = lcnt[w * 32 + e]; t += v; b += (w < c) ? v : 0; }
      ptot[sl * 32 + e] = t; pbef[sl * 32 + e] = b; }
    __syncthreads();
    if (tid < 32) { int t = 0, b = 0;
#pragma unroll
        for (int sl = 0; sl < 16; ++sl) { t += ptot[sl * 32 + tid]; b += pbef[sl * 32 + tid]; }
        tot[tid] = t; wof[tid] = b; }
    __syncthreads();
    if (tid == 0) { int ts = 0; for (int e = 0; e < 32; ++e) { const int nt = (tot[e] + 255) >> 8; for (int j = 0; j < nt; ++j) ttab[1 + ts + j] = e; if (want_base) base[e] = ts * 256 + wof[e]; ts += nt; } ttab[0] = ts; }
    __syncthreads();
}

__device__ __forceinline__ void build_tiles2(const unsigned* ecnt, LAS unsigned char* lds) {
    LAS int* ttab = (LAS int*)(lds + MISC_OFF + 256); LAS int* tstart = (LAS int*)(lds + MISC_OFF + 1536); LAS int* tile_l = (LAS int*)(lds + XTRA_OFF);
    if (threadIdx.x < 64) { const int e = threadIdx.x & 31; const int cnt = (int)ecnt[e], nt = (cnt + 255) >> 8; int ts = nt;
#pragma unroll
        for (int o = 1; o < 32; o <<= 1) { const int v = __shfl_up(ts, o, 32); if (e >= o) ts += v; }
        const int first = ts - nt;
        if (threadIdx.x < 32) { tstart[e] = first; for (int j = 0; j < nt; ++j) { ttab[1 + first + j] = e; tile_l[first + j] = e * LCAP + j * 256; } if (e == 31) ttab[0] = ts; } }
    __syncthreads();
}

__global__ void __launch_bounds__(NWAVES * 64, 2) fwd_kernel(Args args) {
    extern __shared__ __attribute__((aligned(16))) unsigned char lds_raw[];
    LAS unsigned char* lds = (LAS unsigned char*)lds_raw;
    const int tid = threadIdx.x, lane = tid & 63, wave = __builtin_amdgcn_readfirstlane(tid >> 6);
    const int G = gridDim.x, c = blockIdx.x;
    const int gw = c * NWAVES + wave, NGW = G * NWAVES;
    unsigned char* ws = args.ws;
    unsigned* ctl = (unsigned*)(ws + WS_CTL);
    const float* x = args.in[0]; const float* cvec = args.in[1]; const float* w_mod = args.in[2]; const float* b_mod = args.in[3];
    const float* g_pre_mix = args.in[4]; const float* g_post_mix = args.in[5]; const float* w_in = args.in[6]; const float* g_gmlp_v = args.in[7];
    const float* w_spatial = args.in[8]; const float* b_spatial = args.in[9]; const float* g_out_gmlp = args.in[10]; const float* g_out_attn = args.in[11];
    const float* w_out = args.in[12]; const float* g_pre_ffn = args.in[13]; const float* g_post_ffn = args.in[14];
    const float* w_rg = args.in[15]; const float* b_rg = args.in[16]; const float* w_re = args.in[17]; const float* b_re = args.in[18];
    const float* w_gate = args.in[19]; const float* w_up = args.in[20]; const float* w_down = args.in[21];
    float* out = args.out;
    int* ROWTOK = (int*)(ws + WS_ROWTOK); float* MOD = (float*)(ws + WS_MOD); bf16* WSM = (bf16*)(ws + WS_WSM); float* YASS = (float*)(ws + WS_YASS);
    int* EID = (int*)(ws + WS_EID); int* LRANK = (int*)(ws + WS_LRANK); float* WT = (float*)(ws + WS_WT); int* TOKPOS = (int*)(ws + WS_TOKPOS); int* LIST = (int*)(ws + WS_LIST); unsigned* ECNT = ctl + CW_ECNT;
    float* ML = (float*)(ws + WS_ML); bf16* WRF = (bf16*)(ws + WS_WRF);
    bf16* WIN = (bf16*)(ws + WS_WIN); bf16* WOUT = (bf16*)(ws + WS_WOUT); unsigned char* WGU = ws + WS_WGU; unsigned char* WDN = ws + WS_WDN; unsigned char* HB8 = ws + WS_HB;
    bf16* HB = (bf16*)(ws + WS_HB); unsigned char* YC8 = ws + WS_HB + 64 * MiB; bf16* PROJ = (bf16*)(ws + WS_PROJ); bf16* QKV = (bf16*)(ws + WS_QKV); unsigned char* OPART = ws + WS_OPART; unsigned char* Y1 = ws + WS_Y1;
    float* VST = (float*)(ws + 20 * MiB);
    unsigned char* ACT = ws + WS_ACT; unsigned char* YBUF = ws + WS_YBUF; bf16* X1B = (bf16*)(ws + WS_OPART);

    for (int u = tid; u < 2048 / 4; u += NWAVES * 64) ((LAS unsigned*)(lds + MISC_OFF))[u] = 0u;
    __syncthreads();
    XcdBarrier bar; bar.bar = ctl + CW_BAR; bar.x = 0; bar.st = nullptr;
    if (MK_N_LAUNCHES == 1) bar = xcd_barrier_post(ctl + CW_BAR, (volatile LAS unsigned*)(lds + MISC_OFF));
    const int lo = args.ph_lo, hi = args.ph_hi;
#define IN(k) (lo <= (k) && (k) < hi)
    unsigned long long t_ext = 0, t_ph = kAnyAmp ? __builtin_amdgcn_s_memrealtime() : 0ull;
#define TSTAMP(k) do { if constexpr (kAnyAmp) { const unsigned long long now_ = __builtin_amdgcn_s_memrealtime(); t_ext += (now_ - t_ph) * (unsigned long long)kAmp[k]; t_ph = now_; } } while (0)
#define SEAM(k) do { if (MK_N_LAUNCHES == 1 && IN(k) && IN((k) + 1)) xcd_barrier(bar); TSTAMP(k); } while (0)

    if (IN(0)) {
        {
            LAS float* sc = (LAS float*)lds; LAS float* red = (LAS float*)(lds + 32768);
            const int kg = tid >> 4, cl = tid & 15;
            for (int u = c; u < NMOD / 64; u += G) {
                const int n0 = u * 64;
                for (int i = tid; i < NB * DM; i += 512) sc[i] = silu_f(cvec[i]);
                __syncthreads();
                float acc[4][4];
#pragma unroll
                for (int b = 0; b < 4; ++b)
#pragma unroll
                    for (int j = 0; j < 4; ++j) acc[b][j] = 0.f;
#pragma unroll 4
                for (int k = kg; k < DM; k += 32) { const f32x4 w = *(const f32x4*)(w_mod + (size_t)k * NMOD + n0 + 4 * cl);
#pragma unroll
                    for (int b = 0; b < 4; ++b) { const float s = sc[b * DM + k];
#pragma unroll
                        for (int j = 0; j < 4; ++j) acc[b][j] += s * w[j]; } }
#pragma unroll
                for (int b = 0; b < 4; ++b)
#pragma unroll
                    for (int j = 0; j < 4; ++j) red[(kg * 4 + b) * 64 + 4 * cl + j] = acc[b][j];
                __syncthreads();
                if (tid < 256) { const int b = tid >> 6, n = tid & 63; float s = 0.f; for (int q = 0; q < 32; ++q) s += red[(q * 4 + b) * 64 + n]; MOD[b * NMOD + n0 + n] = s + b_mod[n0 + n]; }
                asm volatile("s_waitcnt vmcnt(0)" ::: "memory");
                __syncthreads();
                if (tid == 0 && u < 64) { __builtin_amdgcn_fence(__ATOMIC_RELEASE, "agent"); (void)xb_add(ctl + CW_MODC, 1u); }
            }
        }
        {
            LAS float* scr = (LAS float*)(lds + wave * 16896);
            constexpr int I_IN = 16 * 160, I_OUT = 16 * 64, I_G = 16 * 32 * 32, I_D = 8 * 64 * 32;
            constexpr int NITEMS = I_IN + I_OUT + 2 * I_G + I_D;
            const int NMODU = NMOD / 64, NTAIL = (G > NMODU && G == 256) ? 3 * (G - NMODU) * NWAVES : 0, N1 = NITEMS - NTAIL;
            const int cl = lane & 7, kq = lane >> 3, c4 = lane >> 4, nn = lane & 15;
            const float* src; unsigned char* dst; int N, ldk;
#define P0_DECODE(it_) do { int r = (it_); \
                if (r < I_IN) { const int kb = r / 160, nb = r % 160; N = DIN; ldk = DM; src = w_in + (size_t)(kb * 128) * DIN + nb * 32; dst = (unsigned char*)WIN + (size_t)(nb * 32) * DM + kb * 128; } \
                else if ((r -= I_IN) < I_OUT) { const int kb = r / 64, nb = r % 64; N = DM; ldk = DM; src = w_out + (size_t)(kb * 128) * DM + nb * 32; dst = (unsigned char*)WOUT + (size_t)(nb * 32) * DM + kb * 128; } \
                else if ((r -= I_OUT) < 2 * I_G) { const int up = r >= I_G; if (up) r -= I_G; const int e = r / 512, q = r % 512, kb = q / 32, nb = q % 32, n0 = nb * 32; \
                    N = DE; ldk = DM; src = (up ? w_up : w_gate) + (size_t)e * DM * DE + (size_t)(kb * 128) * DE + n0; dst = WGU + ((size_t)(e * 8 + (n0 >> 7)) * 256 + (n0 & 127) + (up ? 128 : 0)) * DM + kb * 128; } \
                else { r -= 2 * I_G; const int e = r / 512, q = r % 512, kb = q / 64, nb = q % 64; N = DM; ldk = DE; src = w_down + (size_t)e * DE * DM + (size_t)(kb * 128) * DM + nb * 32; dst = WDN + ((size_t)e * DM + nb * 32) * DE + kb * 128; } } while (0)
#define P0_LOAD() do { _Pragma("unroll") for (int i = 0; i < 16; ++i) tv[i] = __builtin_nontemporal_load((const f32x4*)(src + (size_t)(8 * i + kq) * N + 4 * cl)); } while (0)
#define P0_NEXT(it_, pass_) do { if (pass_ == 0) { it_ += NGW; if (it_ >= N1) { pass_ = 1; it_ = (c >= NMODU) ? N1 + (c - NMODU) * NWAVES + wave : NITEMS; } } else it_ += (G - NMODU) * NWAVES; } while (0)
            f32x4 tv[16];
            int it = gw, pass = 0;
            if (it >= N1) { pass = 1; it = (c >= NMODU) ? N1 + (c - NMODU) * NWAVES + wave : NITEMS; }
            if (it < NITEMS) { P0_DECODE(it); P0_LOAD(); }
            while (it < NITEMS) {
                unsigned char* const dcur = dst; const int lcur = ldk;
#pragma unroll
                for (int i = 0; i < 16; ++i) { LAS float* s = scr + (8 * i + kq) * 33 + 4 * cl; s[0] = tv[i][0]; s[1] = tv[i][1]; s[2] = tv[i][2]; s[3] = tv[i][3]; }
                P0_NEXT(it, pass);
                if (it < NITEMS) { P0_DECODE(it); P0_LOAD(); }
                asm volatile("s_waitcnt lgkmcnt(0)" ::: "memory");
#pragma unroll
                for (int i2 = 0; i2 < 2; ++i2)
#pragma unroll
                    for (int hh = 0; hh < 2; ++hh) { const int n = nn + 16 * i2, kc = 16 * (c4 + 4 * hh); const LAS float* s = scr + kc * 33 + n; u32x4 o;
                        o.x = cvt4_fp8(64.f * s[0], 64.f * s[33], 64.f * s[2 * 33], 64.f * s[3 * 33]); o.y = cvt4_fp8(64.f * s[4 * 33], 64.f * s[5 * 33], 64.f * s[6 * 33], 64.f * s[7 * 33]);
                        o.z = cvt4_fp8(64.f * s[8 * 33], 64.f * s[9 * 33], 64.f * s[10 * 33], 64.f * s[11 * 33]); o.w = cvt4_fp8(64.f * s[12 * 33], 64.f * s[13 * 33], 64.f * s[14 * 33], 64.f * s[15 * 33]);
                        __builtin_nontemporal_store(o, (u32x4*)(dcur + (size_t)n * lcur + kc)); }
                asm volatile("s_waitcnt lgkmcnt(0)" ::: "memory");
            }
#undef P0_DECODE
#undef P0_LOAD
#undef P0_NEXT
        }
        for (int i = c * 512 + tid; i < 8 * 128 * 128; i += G * 512) { const int s = i & 127, t = (i >> 7) & 127; const float v = s <= t ? w_spatial[i] : 0.f; WSM[i] = (bf16)(cvtpk(v, 0.f) & 0xffffu); }
        for (int i = c * 512 + tid; i < 384 * 64; i += G * 512) {
            const int fl = i & 63, frag = i >> 6, part = frag & 1, nt = (frag >> 1) % 3, ks = (frag >> 1) / 3, n = 16 * nt + (fl & 15); float f[8];
#pragma unroll
            for (int j = 0; j < 8; ++j) { const int k = 32 * ks + 8 * (fl >> 4) + j; float w = 0.f;
                if (n < 4) w = w_rg[(size_t)k * 4 + n]; else if (n < 36) w = w_re[((size_t)((n - 4) >> 3) * DM + k) * 8 + ((n - 4) & 7)];
                const float hi = bflo(cvtpk(w, 0.f)); f[j] = part ? (w - hi) : hi; }
            *(u32x4*)(WRF + (size_t)i * 8) = pack8(f); }
    }
    TSTAMP(0);

    if (IN(1)) {
        if (MK_N_LAUNCHES == 1 && IN(0)) { if (tid == 0) { XB_SPIN(xb_ld(ctl + CW_MODC) < 64u, bar.bar); __builtin_amdgcn_fence(__ATOMIC_ACQUIRE, "agent"); } __syncthreads(); }
        const int RPW = NTOK / NGW, row0 = gw * RPW, b = row0 / SEQ;
        float av[32], sv[32];
#pragma unroll
        for (int j = 0; j < 4; ++j)
#pragma unroll
            for (int i = 0; i < 8; ++i) { const int ch = 512 * j + 8 * lane + i; av[8 * j + i] = g_pre_mix[ch] * (1.0f + MOD[b * NMOD + 1 * DM + ch]); sv[8 * j + i] = MOD[b * NMOD + 0 * DM + ch]; }
        for (int r = 0; r < RPW; ++r) {
            const float* xr = x + (size_t)(row0 + r) * DM; float xv[32]; float ss = 0.f;
#pragma unroll
            for (int j = 0; j < 4; ++j) { const f32x4 a = __builtin_nontemporal_load((const f32x4*)(xr + 512 * j + 8 * lane)), bq = __builtin_nontemporal_load((const f32x4*)(xr + 512 * j + 8 * lane + 4));
#pragma unroll
                for (int i = 0; i < 4; ++i) { xv[8 * j + i] = a[i]; xv[8 * j + 4 + i] = bq[i]; ss += a[i] * a[i] + bq[i] * bq[i]; } }
            const float rstd = __builtin_amdgcn_rsqf(wave_sum(ss) * (1.0f / DM) + EPS);
            unsigned char* hr = (unsigned char*)HB + (size_t)(row0 + r) * DM;
#pragma unroll
            for (int j = 0; j < 4; ++j) { float f[8];
#pragma unroll
                for (int i = 0; i < 8; ++i) f[i] = xv[8 * j + i] * rstd * av[8 * j + i] + sv[8 * j + i];
                u32x2 h8; h8.x = cvt4_fp8(f[0], f[1], f[2], f[3]); h8.y = cvt4_fp8(f[4], f[5], f[6], f[7]); *(u32x2*)(hr + 512 * j + 8 * lane) = h8; }
        }
    }
    SEAM(1);

    if (IN(2)) {
        pg8::Gemm g{HB, WIN, DM / 2, DM / 2, nullptr, -6, nullptr}; pg8::StaticOrder S; S.init(NTOK / 256, DIN / 256, G, c);
        pg8::EpiInProj E{PROJ, PP, QKV, VST};
        pg8::gemm_phase<pg8::EpiInProj, pg8::StaticOrder, false, false, true>(lds, g, S, E);
    }
    SEAM(2);

    if (IN(3)) {
        {
            LAS unsigned char* VT = lds; LAS f32x2* stats = (LAS f32x2*)(lds + 81920); LAS float* ssqL = (LAS float*)(lds + 83968);
            const int r32 = lane & 31, hh2 = lane >> 5, blk = (lane >> 4) & 1, q4 = (lane & 15) >> 2, p4 = lane & 3;
            const int tb = wave & 3, dh = wave >> 2;
            for (int u = c; u < NTOK / 128; u += G) {
                const int t0 = u * 128;
                if (tid < 128) {
                    const f32x4* pp = (const f32x4*)(VST + (size_t)(t0 + tid) * 32); float s1 = 0.f, s2 = 0.f;
#pragma unroll
                    for (int k = 0; k < 8; ++k) { const f32x4 v = pp[k]; s1 += v[0] + v[2]; s2 += v[1] + v[3]; }
                    const float mean = s1 * (1.0f / DG), var = s2 * (1.0f / DG) - mean * mean;
                    stats[tid] = (f32x2){mean, __builtin_amdgcn_rsqf(fmaxf(var, 0.f) + EPS)}; }
                __syncthreads();
                float ssq4[4] = {0.f, 0.f, 0.f, 0.f};
#define P3_VLOAD(dst_, hh_) do { _Pragma("unroll") for (int q = 0; q < 4; ++q) { const int idx = tid + 512 * q, s = idx >> 4, ch = idx & 15; \
                    dst_[q] = *(const u32x4*)(PROJ + (size_t)(t0 + s) * PP + DG + (hh_) * 128 + 8 * ch); } } while (0)
#define P3_VWRITE(src_, hh_, buf_) do { _Pragma("unroll") for (int q = 0; q < 4; ++q) { const int idx = tid + 512 * q, s = idx >> 4, ch = idx & 15; float f[8]; unpack8(src_[q], f); \
                    const f32x2 st = stats[s]; const f32x4 ga = *(const f32x4*)(g_gmlp_v + (hh_) * 128 + 8 * ch), gb = *(const f32x4*)(g_gmlp_v + (hh_) * 128 + 8 * ch + 4); \
                    _Pragma("unroll") for (int i = 0; i < 4; ++i) { f[i] = (f[i] - st.x) * st.y * ga[i]; f[4 + i] = (f[4 + i] - st.x) * st.y * gb[i]; } \
                    *(LAS u32x4*)(VT + (buf_) * 40960 + s * 320 + ch * 16) = pack8(f); } } while (0)
                u32x4 vraw[4];
                P3_VLOAD(vraw, 0); P3_VWRITE(vraw, 0, 0);
                __syncthreads();
                const int nks = 2 * (tb + 1);
                bf16x8 bwf[8];
                { const bf16* wrow = WSM + ((size_t)(32 * tb + r32)) * 128 + 8 * hh2;
#pragma unroll
                  for (int ks = 0; ks < 8; ++ks) bwf[ks] = *(const bf16x8*)(wrow + 16 * (ks < nks ? ks : 0)); }
                for (int hh = 0; hh < 8; ++hh) {
                    const int buf = hh & 1, hn = hh + 1 < 8 ? hh + 1 : hh;
                    P3_VLOAD(vraw, hn);
                    u32x4 uraw[4]; float bsp4[4];
                    const f32x4 gya = *(const f32x4*)(g_out_gmlp + hh * 128 + 64 * dh + 8 * (lane & 7)), gyb = *(const f32x4*)(g_out_gmlp + hh * 128 + 64 * dh + 8 * (lane & 7) + 4);
#pragma unroll
                    for (int i = 0; i < 4; ++i) { const int row = (lane >> 3) + 8 * i; uraw[i] = *(const u32x4*)(PROJ + (size_t)(t0 + 32 * tb + row) * PP + hh * 128 + 64 * dh + 8 * (lane & 7)); bsp4[i] = b_spatial[hh * 128 + 32 * tb + row]; }
                    f32x16 acc0 = {}, acc1 = {};
                    const LAS unsigned char* vb = VT + buf * 40960 + (8 * hh2 + q4) * 320 + (64 * dh + 16 * blk + 4 * p4) * 2;
#pragma unroll
                    for (int ks = 0; ks < 8; ++ks) if (ks < nks) {
                        const LAS unsigned char* vk = vb + ks * 16 * 320;
                        const s16x4 l0 = vtr(vk), h0 = vtr(vk + 4 * 320), l1 = vtr(vk + 64), h1 = vtr(vk + 4 * 320 + 64);
                        const bf16x8 a0 = {l0[0], l0[1], l0[2], l0[3], h0[0], h0[1], h0[2], h0[3]}, a1 = {l1[0], l1[1], l1[2], l1[3], h1[0], h1[1], h1[2], h1[3]};
                        acc0 = MFMA32(a0, bwf[ks], acc0); acc1 = MFMA32(a1, bwf[ks], acc1);
                    }
                    { const bf16* wrow = WSM + ((size_t)(hn * 128 + 32 * tb + r32)) * 128 + 8 * hh2;
#pragma unroll
                      for (int ks = 0; ks < 8; ++ks) bwf[ks] = *(const bf16x8*)(wrow + 16 * (ks < nks ? ks : 0)); }
                    {
                        LAS unsigned char* stg = lds + 86016 + wave * 8704;
#pragma unroll
                        for (int db = 0; db < 2; ++db)
#pragma unroll
                            for (int gq = 0; gq < 4; ++gq) { const f32x16& A = db ? acc1 : acc0;
                                *(LAS f32x4*)(stg + r32 * 272 + (32 * db + 8 * gq + 4 * hh2) * 4) = (f32x4){A[4 * gq + 0], A[4 * gq + 1], A[4 * gq + 2], A[4 * gq + 3]}; }
                        asm volatile("s_waitcnt lgkmcnt(0)" ::: "memory");
#pragma unroll
                        for (int i = 0; i < 4; ++i) { const int row = (lane >> 3) + 8 * i, ch = lane & 7;
                            unsigned char* pu = YC8 + (size_t)(t0 + 32 * tb + row) * DM + hh * 128 + 64 * dh + 8 * ch;
                            const f32x4 s0 = *(const LAS f32x4*)(stg + row * 272 + ch * 32), s1 = *(const LAS f32x4*)(stg + row * 272 + ch * 32 + 16);
                            float f[8]; unpack8(uraw[i], f); const float bsp = bsp4[i];
#pragma unroll
                            for (int j = 0; j < 4; ++j) { f[j] *= (s0[j] + bsp); f[4 + j] *= (s1[j] + bsp); }
#pragma unroll
                            for (int j = 0; j < 8; ++j) ssq4[i] += f[j] * f[j];
                            u32x2 o; o.x = cvt4_fp8(f[0] * gya[0], f[1] * gya[1], f[2] * gya[2], f[3] * gya[3]); o.y = cvt4_fp8(f[4] * gyb[0], f[5] * gyb[1], f[6] * gyb[2], f[7] * gyb[3]);
                            *(u32x2*)pu = o; }
                        asm volatile("s_waitcnt lgkmcnt(0)" ::: "memory");
                    }
                    if (hh + 1 < 8) P3_VWRITE(vraw, hh + 1, buf ^ 1);
                    __syncthreads();
                }
#undef P3_VLOAD
#undef P3_VWRITE
#pragma unroll
                for (int i = 0; i < 4; ++i) { float q = ssq4[i]; q += __shfl_xor(q, 1); q += __shfl_xor(q, 2); q += __shfl_xor(q, 4); if ((lane & 7) == 0) ssqL[wave * 32 + (lane >> 3) + 8 * i] = q; }
                __syncthreads();
                if (tid < 128) YASS[t0 + tid] = ssqL[(tid >> 5) * 32 + (tid & 31)] + ssqL[((tid >> 5) + 4) * 32 + (tid & 31)];
                __syncthreads();
            }
        }
    }
    TSTAMP(3);
    if (IN(4)) {
        LAS unsigned char* KT = lds; LAS unsigned char* VT = lds + 65536; LAS unsigned char* QT = lds + 131072;
        const unsigned keep0 = ((volatile LAS unsigned*)(lds + MISC_OFF))[0], keep1 = ((volatile LAS unsigned*)(lds + MISC_OFF))[1];
        __syncthreads();
        const int fr = lane & 15, g = lane >> 4, q4 = (lane & 15) >> 2, p4 = lane & 3;
        const int UPW = 6144 / G;
        unsigned vaddr[8];
#pragma unroll
        for (int db = 0; db < 8; ++db) vaddr[db] = (unsigned)(size_t)(VT + (16 * wave + 4 * g + q4) * 256 + 8 * p4 + ((db ^ (4 * (g & 1) + q4)) << 5));
        const int lrow = 16 * wave + (lane >> 4);
        const int sw0 = ((((lane & 15) >> 1) ^ (lane >> 4)) << 4) + ((lane & 1) << 3), sw1 = ((((lane & 15) >> 1) ^ (4 + (lane >> 4))) << 4) + ((lane & 1) << 3);
#define P4_DECODE(uid_, pat_, tbase_, hbase_, dl_, qb_, head_) do { const int bh_ = (uid_) / 192, r_ = (uid_) % 192, xq_ = r_ & 63; pat_ = r_ >> 6; \
            dl_ = pat_ == 0 ? 1 : (pat_ == 1 ? 4 : 16); const int nblk_ = 64 / dl_, res_ = xq_ / nblk_; qb_ = xq_ % nblk_; head_ = bh_ & 7; tbase_ = (size_t)(bh_ >> 3) * SEQ + res_; hbase_ = (size_t)bh_ * SEQ + res_; } while (0)
#define P4_ISSUE(T_, which_, hbase_, dl_, qb_, blk_) do { const bf16* b_ = QKV + (size_t)(which_) * NTOK * 1024 + (hbase_) * 128; const int m0_ = 128 * (qb_) - 128 + 128 * (blk_) + lrow; const int xr_ = ((qb_) & 1) ? 0 : 128; \
            _Pragma("unroll") for (int i_ = 0; i_ < 4; ++i_) { int mk_ = m0_ + 4 * i_; mk_ = mk_ < 0 ? 0 : mk_; \
            __builtin_amdgcn_global_load_lds((const unsigned*)(b_ + (size_t)(mk_ * (dl_)) * 128 + ((i_ & 1) ? sw1 : sw0)), (LAS unsigned*)((T_) + (((128 * (blk_) + 16 * wave + 4 * i_) ^ xr_) << 8)), 16, 0, 0); } } while (0)
#define P4_QISSUE(hbase_, dl_, qb_) do { const bf16* q_ = QKV + ((hbase_) + (size_t)(128 * (qb_) + 16 * wave + (lane >> 4)) * (dl_)) * 128; \
            _Pragma("unroll") for (int i_ = 0; i_ < 4; ++i_) \
            __builtin_amdgcn_global_load_lds((const unsigned*)(q_ + (size_t)(4 * i_ * (dl_)) * 128 + ((i_ & 1) ? sw1 : sw0)), (LAS unsigned*)(QT + (16 * wave + 4 * i_) * 256), 16, 0, 0); } while (0)
        int pat, dl, qb, head; size_t tbase, hbase;
        const int vc = (((c & 7) + 8 * (c >> 6)) << 3) + ((c >> 3) & 7);
#define P4_UID(ui_) (((vc >> 3) * 192) + 64 * ((ui_) >> 3) + 8 * (vc & 7) + ((ui_) & 7))
        { const int uid0 = P4_UID(0); P4_DECODE(uid0, pat, tbase, hbase, dl, qb, head); P4_ISSUE(KT, 1, hbase, dl, qb, 0); P4_ISSUE(KT, 1, hbase, dl, qb, 1); P4_QISSUE(hbase, dl, qb); P4_ISSUE(VT, 2, hbase, dl, qb, 0); P4_ISSUE(VT, 2, hbase, dl, qb, 1); }
        bool both = true;
        for (int ui = 0; ui < UPW; ++ui) {
            const size_t tq = tbase + (size_t)(128 * qb + 16 * wave + fr) * dl;
            const unsigned xb = (qb & 1) ? 0u : 0x8000u;
            if (ui == 0) asm volatile("s_waitcnt vmcnt(8)" ::: "memory"); else if (both) asm volatile("s_waitcnt vmcnt(11)" ::: "memory"); else asm volatile("s_waitcnt vmcnt(7)" ::: "memory");
            __builtin_amdgcn_s_barrier(); asm volatile("" ::: "memory");
            f32x4 S[9];
            {
                const unsigned kb0 = (unsigned)(size_t)(KT + (16 * wave + fr) * 256 + ((g & 1) << 4));
                const LAS unsigned char* qb0 = QT + (16 * wave + fr) * 256 + ((g & 1) << 4);
                const int sw = fr & 7;
                bf16x8 qf[4];
#pragma unroll
                for (int ks = 0; ks < 4; ++ks) qf[ks] = *(const LAS bf16x8*)(qb0 + (((2 * ks + (g >> 1)) ^ sw) << 5));
                bf16x8 kf[9][4];
#pragma unroll
                for (int kb = 0; kb < 9; ++kb)
#pragma unroll
                    for (int ks = 0; ks < 4; ++ks) kf[kb][ks] = *(const LAS bf16x8*)(size_t)(((kb0 + kb * 4096) ^ xb) + (((2 * ks + (g >> 1)) ^ sw) << 5));
#pragma unroll
                for (int kb = 0; kb < 9; ++kb) { f32x4 a = {0.f, 0.f, 0.f, 0.f};
#pragma unroll
                    for (int ks = 0; ks < 4; ++ks) a = __builtin_amdgcn_mfma_f32_16x16x32_bf16(kf[kb][ks], qf[ks], a, 0, 0, 0);
                    S[kb] = a; }
            }
            const int mk0 = 128 * qb - 128 + 16 * wave;
#pragma unroll
            for (int r = 0; r < 4; ++r) { if (4 * g + r < fr) S[0][r] = -INFINITY; if (4 * g + r > fr) S[8][r] = -INFINITY; }
            if (mk0 < 0) {
#pragma unroll
                for (int kb = 0; kb < 9; ++kb)
#pragma unroll
                    for (int r = 0; r < 4; ++r) if (mk0 + 16 * kb + 4 * g + r < 0) S[kb][r] = -INFINITY; }
            float mx = -INFINITY;
#pragma unroll
            for (int kb = 0; kb < 9; ++kb)
#pragma unroll
                for (int r = 0; r < 4; ++r) mx = fmaxf(mx, S[kb][r]);
            mx = fmaxf(mx, __shfl_xor(mx, 16)); mx = fmaxf(mx, __shfl_xor(mx, 32));
            float lsum = 0.f;
#pragma unroll
            for (int kb = 0; kb < 9; ++kb)
#pragma unroll
                for (int r = 0; r < 4; ++r) { const float pv = __builtin_amdgcn_exp2f(S[kb][r] - mx); S[kb][r] = pv; lsum += pv; }
            lsum += __shfl_xor(lsum, 16); lsum += __shfl_xor(lsum, 32);
            bf16x8 pf[5];
#pragma unroll
            for (int s2 = 0; s2 < 5; ++s2) { u32x4 w; w.x = cvtpk(S[2 * s2][0], S[2 * s2][1]); w.y = cvtpk(S[2 * s2][2], S[2 * s2][3]);
                if (s2 < 4) { w.z = cvtpk(S[2 * s2 + 1][0], S[2 * s2 + 1][1]); w.w = cvtpk(S[2 * s2 + 1][2], S[2 * s2 + 1][3]); } else { w.z = 0u; w.w = 0u; }
                pf[s2] = __builtin_bit_cast(bf16x8, w); }
            asm volatile("s_waitcnt vmcnt(0) lgkmcnt(0)" ::: "memory"); __builtin_amdgcn_s_barrier(); asm volatile("" ::: "memory");
            int pat_n, dl_n, qb_n, head_n; size_t tbase_n, hbase_n;
            const bool more = ui + 1 < UPW;
            const int uidc = P4_UID(ui), uidn = more ? P4_UID(ui + 1) : uidc;
            { P4_DECODE(uidn, pat_n, tbase_n, hbase_n, dl_n, qb_n, head_n); }
            const bool both_n = more && !(uidn == uidc + 1 && qb_n != 0);
            if (both_n) P4_ISSUE(KT, 1, hbase_n, dl_n, qb_n, 0);
            P4_ISSUE(KT, 1, hbase_n, dl_n, qb_n, 1); P4_QISSUE(hbase_n, dl_n, qb_n);
            f32x4 O[8];
#pragma unroll
            for (int db = 0; db < 8; ++db) O[db] = (f32x4){0.f, 0.f, 0.f, 0.f};
            {
                unsigned va[8];
#pragma unroll
                for (int db = 0; db < 8; ++db) va[db] = vaddr[db] ^ xb;
                s16x4 LA[8], HA[8], LB[8], HB_[8];
#define P4_TR(dst_, db_, off_) do { const unsigned a_ = (vaddr[db_] + (off_)) ^ xb; asm volatile("ds_read_b64_tr_b16 %0, %1" : "=v"(dst_) : "v"(a_) : "memory"); } while (0)
#define P4_RD(L_, H_, s2_) do { _Pragma("unroll") for (int db = 0; db < 8; ++db) { P4_TR(L_[db], db, (s2_) * 8192); P4_TR(H_[db], db, (s2_) < 4 ? (s2_) * 8192 + 4096 : (s2_) * 8192); } } while (0)
#define P4_WT(L_, H_) do { asm volatile("s_waitcnt lgkmcnt(0)" : "+v"(L_[0]), "+v"(L_[1]), "+v"(L_[2]), "+v"(L_[3]), "+v"(L_[4]), "+v"(L_[5]), "+v"(L_[6]), "+v"(L_[7]), \
                    "+v"(H_[0]), "+v"(H_[1]), "+v"(H_[2]), "+v"(H_[3]), "+v"(H_[4]), "+v"(H_[5]), "+v"(H_[6]), "+v"(H_[7]) :: "memory"); __builtin_amdgcn_sched_barrier(0); } while (0)
#define P4_MM(L_, H_, s2_) do { _Pragma("unroll") for (int db = 0; db < 8; ++db) { const bf16x8 av = {L_[db][0], L_[db][1], L_[db][2], L_[db][3], H_[db][0], H_[db][1], H_[db][2], H_[db][3]}; \
                    O[db] = __builtin_amdgcn_mfma_f32_16x16x32_bf16(av, pf[s2_], O[db], 0, 0, 0); } } while (0)
                (void)va;
                P4_RD(LA, HA, 0); P4_WT(LA, HA);
                P4_RD(LB, HB_, 1); P4_MM(LA, HA, 0); P4_WT(LB, HB_);
                P4_RD(LA, HA, 2); P4_MM(LB, HB_, 1); P4_WT(LA, HA);
                P4_RD(LB, HB_, 3); P4_MM(LA, HA, 2); P4_WT(LB, HB_);
                P4_RD(LA, HA, 4); P4_MM(LB, HB_, 3); P4_WT(LA, HA);
                P4_MM(LA, HA, 4);
#undef P4_TR
#undef P4_RD
#undef P4_WT
#undef P4_MM
            }
            asm volatile("s_waitcnt lgkmcnt(0)" ::: "memory"); __builtin_amdgcn_s_barrier(); asm volatile("" ::: "memory");
            {
                LAS unsigned char* stg = VT + (((16 * wave) << 8) ^ xb);
#pragma unroll
                for (int db = 0; db < 8; ++db) *(LAS unsigned*)(stg + fr * 128 + ((db ^ (fr & 7)) << 4) + 4 * g) = cvt4_fp8(O[db][0], O[db][1], O[db][2], O[db][3]);
                asm volatile("s_waitcnt lgkmcnt(0)" ::: "memory");
                u32x4 ov[2];
#pragma unroll
                for (int i = 0; i < 2; ++i) { const int r = 8 * i + (lane >> 3); ov[i] = *(const LAS u32x4*)(stg + r * 128 + (((lane & 7) ^ (r & 7)) << 4)); }
                asm volatile("s_waitcnt lgkmcnt(0)" ::: "memory");
                const size_t tq8 = tbase + (size_t)(128 * qb + 16 * wave + (lane >> 3)) * dl;
                unsigned char* ob = OPART + ((size_t)pat * NTOK + tq8) * DG + head * 128 + 16 * (lane & 7);
#pragma unroll
                for (int i = 0; i < 2; ++i) __builtin_nontemporal_store(ov[i], (u32x4*)(ob + (size_t)(8 * i * dl) * DG));
            }
            if (both_n) P4_ISSUE(VT, 2, hbase_n, dl_n, qb_n, 0);
            P4_ISSUE(VT, 2, hbase_n, dl_n, qb_n, 1);
            *(f32x2*)(ML + (((size_t)pat * NTOK + tq) * 8 + head) * 2) = (f32x2){mx, lsum};
            pat = pat_n; dl = dl_n; qb = qb_n; head = head_n; tbase = tbase_n; hbase = hbase_n; both = both_n;
        }
        asm volatile("s_waitcnt vmcnt(0)" ::: "memory");
        __syncthreads();
        if (tid == 0) { ((volatile LAS unsigned*)(lds + MISC_OFF))[0] = keep0; ((volatile LAS unsigned*)(lds + MISC_OFF))[1] = keep1; }
        __syncthreads();
#undef P4_DECODE
#undef P4_ISSUE
#undef P4_QISSUE
#undef P4_UID
    }
    SEAM(4);

    if (IN(5)) {
        const int RPW = NTOK / NGW, row0 = gw * RPW, head = lane >> 3;
        float ga[16], gb[16];
#pragma unroll
        for (int i = 0; i < 16; ++i) { ga[i] = g_out_gmlp[16 * lane + i]; gb[i] = g_out_attn[16 * lane + i]; }
        for (int r = 0; r < RPW; ++r) {
            const size_t row = (size_t)(row0 + r);
            f32x2 ml[3]; float M = -INFINITY;
#pragma unroll
            for (int p = 0; p < 3; ++p) { ml[p] = *(const f32x2*)(ML + (((size_t)p * NTOK + row) * 8 + head) * 2); M = fmaxf(M, ml[p].x); }
            float o[16]; float den = 0.f;
#pragma unroll
            for (int i = 0; i < 16; ++i) o[i] = 0.f;
#pragma unroll
            for (int p = 0; p < 3; ++p) { const float w = __builtin_amdgcn_exp2f(ml[p].x - M); den += w * ml[p].y;
                const unsigned char* op = OPART + ((size_t)p * NTOK + row) * DG + 16 * lane; float f[8], f2[8]; const u32x4 o8 = __builtin_nontemporal_load((const u32x4*)op); unpack8_fp8((u32x2){o8.x, o8.y}, f); unpack8_fp8((u32x2){o8.z, o8.w}, f2);
#pragma unroll
                for (int i = 0; i < 8; ++i) { o[i] += w * f[i]; o[8 + i] += w * f2[i]; } }
            const float inv = 1.0f / den; float ss = 0.f;
#pragma unroll
            for (int i = 0; i < 16; ++i) { o[i] *= inv; ss += o[i] * o[i]; }
            const float rb = __builtin_amdgcn_rsqf(wave_sum(ss) * (1.0f / DG) + EPS);
            unsigned char* yc = YC8 + row * DM + 16 * lane;
            { u32x4 w8; w8.x = cvt4_fp8(o[0] * rb * gb[0], o[1] * rb * gb[1], o[2] * rb * gb[2], o[3] * rb * gb[3]); w8.y = cvt4_fp8(o[4] * rb * gb[4], o[5] * rb * gb[5], o[6] * rb * gb[6], o[7] * rb * gb[7]);
              w8.z = cvt4_fp8(o[8] * rb * gb[8], o[9] * rb * gb[9], o[10] * rb * gb[10], o[11] * rb * gb[11]); w8.w = cvt4_fp8(o[12] * rb * gb[12], o[13] * rb * gb[13], o[14] * rb * gb[14], o[15] * rb * gb[15]);
              *(u32x4*)(yc + DG) = w8; }
        }
    }
    SEAM(5);

    if (IN(6)) {
        pg8::Gemm g{(const bf16*)YC8, WOUT, DM / 2, DM / 2, nullptr, -6, YASS}; pg8::StaticOrder S; S.init(NTOK / 256, DM / 256, G, c);
        pg8::EpiPlain8 E{Y1, DM};
        pg8::gemm_phase<pg8::EpiPlain8, pg8::StaticOrder, false, false, true, 8>(lds, g, S, E);
    }
    SEAM(6);

    if (IN(7)) {
        const int TPW = NTOK / G, tok0 = c * TPW, b = tok0 / SEQ;
        LAS unsigned char* HI = lds; LAS unsigned char* LO = lds + 65536;
        LAS float* A1 = (LAS float*)(lds + 131072); LAS float* A2 = A1 + DM; LAS float* S2 = A2 + DM;
        LAS float* part = (LAS float*)lds;
        LAS float* logit = (LAS float*)(lds + XTRA_OFF);
        LAS int* hist = (LAS int*)(lds + MISC_OFF + 64); LAS int* eidL = (LAS int*)(lds + XTRA_OFF + 2560); LAS int* lrL = eidL + 256;
        for (int i = tid; i < DM; i += 512) { A1[i] = MOD[b * NMOD + 2 * DM + i] * g_post_mix[i]; A2[i] = g_pre_ffn[i] * (1.0f + MOD[b * NMOD + 4 * DM + i]); S2[i] = MOD[b * NMOD + 3 * DM + i]; }
        LAS float* rbias = (LAS float*)(lds + XTRA_OFF + 2304);
        if (tid < 36) rbias[tid] = tid < 4 ? b_rg[tid] : b_re[tid - 4];
        if (tid < 32) hist[tid] = 0;
        __syncthreads();
        const int fr = lane & 15, fq = lane >> 4;
        u32x2 yq[2][4]; f32x4 xq[2][8];
#define P7_LOAD(ti_) do { _Pragma("unroll") for (int rr2 = 0; rr2 < 2; ++rr2) { const int tok_ = tok0 + 16 * (ti_) + 2 * wave + rr2; \
            const float* xr_ = x + (size_t)tok_ * DM + 8 * lane; const unsigned char* yr_ = Y1 + (size_t)tok_ * DM + 8 * lane; \
            _Pragma("unroll") for (int j = 0; j < 4; ++j) { yq[rr2][j] = *(const u32x2*)(yr_ + 512 * j); xq[rr2][2 * j] = __builtin_nontemporal_load((const f32x4*)(xr_ + 512 * j)); xq[rr2][2 * j + 1] = __builtin_nontemporal_load((const f32x4*)(xr_ + 512 * j + 4)); } } } while (0)
        P7_LOAD(0);
        for (int ti = 0; ti < TPW / 16; ++ti) {
#pragma unroll
            for (int rr2 = 0; rr2 < 2; ++rr2) {
                const int rr = 2 * wave + rr2, tok = tok0 + 16 * ti + rr;
                unsigned char* hr = HB8 + (size_t)tok * DM;
                float xv[32], yv[32]; float ss = 0.f;
#pragma unroll
                for (int j = 0; j < 4; ++j) { float f[8]; unpack8_fp8(yq[rr2][j], f);
#pragma unroll
                    for (int i = 0; i < 8; ++i) { yv[8 * j + i] = f[i]; ss += f[i] * f[i]; } }
#pragma unroll
                for (int j = 0; j < 4; ++j) {
#pragma unroll
                    for (int i = 0; i < 4; ++i) { xv[8 * j + i] = xq[rr2][2 * j][i]; xv[8 * j + 4 + i] = xq[rr2][2 * j + 1][i]; } }
                const float r1 = __builtin_amdgcn_rsqf(wave_sum(ss) * (1.0f / DM) + EPS);
                float ss2 = 0.f;
#pragma unroll
                for (int j = 0; j < 4; ++j) { const f32x4 a0 = *(const LAS f32x4*)(A1 + 512 * j + 8 * lane), a1 = *(const LAS f32x4*)(A1 + 512 * j + 8 * lane + 4);
#pragma unroll
                    for (int i = 0; i < 4; ++i) { xv[8 * j + i] += a0[i] * yv[8 * j + i] * r1; xv[8 * j + 4 + i] += a1[i] * yv[8 * j + 4 + i] * r1; }
#pragma unroll
                    for (int i = 0; i < 8; ++i) ss2 += xv[8 * j + i] * xv[8 * j + i];
                    { float f[8];
#pragma unroll
                      for (int i = 0; i < 8; ++i) f[i] = xv[8 * j + i];
                      __builtin_nontemporal_store(pack8(f), (u32x4*)(X1B + (size_t)tok * DM + 512 * j + 8 * lane)); } }
                const float r2 = __builtin_amdgcn_rsqf(wave_sum(ss2) * (1.0f / DM) + EPS);
#pragma unroll
                for (int j = 0; j < 4; ++j) { const f32x4 a0 = *(const LAS f32x4*)(A2 + 512 * j + 8 * lane), a1 = *(const LAS f32x4*)(A2 + 512 * j + 8 * lane + 4);
                    const f32x4 s0 = *(const LAS f32x4*)(S2 + 512 * j + 8 * lane), s1 = *(const LAS f32x4*)(S2 + 512 * j + 8 * lane + 4);
                    float f[8], fl[8];
#pragma unroll
                    for (int i = 0; i < 4; ++i) { f[i] = xv[8 * j + i] * r2 * a0[i] + s0[i]; f[4 + i] = xv[8 * j + 4 + i] * r2 * a1[i] + s1[i]; }
                    const u32x4 hw = pack8(f); float fh[8]; unpack8(hw, fh);
#pragma unroll
                    for (int i = 0; i < 8; ++i) fl[i] = f[i] - fh[i];
                    { u32x2 h8; h8.x = cvt4_fp8(f[0], f[1], f[2], f[3]); h8.y = cvt4_fp8(f[4], f[5], f[6], f[7]); *(u32x2*)(hr + 512 * j + 8 * lane) = h8; }
                    const int off = rr * 4096 + (((64 * j + lane) ^ rr) << 4);
                    *(LAS u32x4*)(HI + off) = hw; *(LAS u32x4*)(LO + off) = pack8(fl); }
            }
            __syncthreads();
            f32x4 acc[3] = {{0.f, 0.f, 0.f, 0.f}, {0.f, 0.f, 0.f, 0.f}, {0.f, 0.f, 0.f, 0.f}};
#pragma unroll 4
            for (int s8 = 0; s8 < 8; ++s8) { const int ks = 8 * wave + s8; const int off = fr * 4096 + (((4 * ks + fq) ^ fr) << 4);
                const bf16x8 ah = *(const LAS bf16x8*)(HI + off), al = *(const LAS bf16x8*)(LO + off);
                const bf16* wf = WRF + ((size_t)(ks * 6) * 64 + lane) * 8;
#pragma unroll
                for (int nt = 0; nt < 3; ++nt) { const bf16x8 bh = *(const bf16x8*)(wf + (size_t)(2 * nt) * 512), bl = *(const bf16x8*)(wf + (size_t)(2 * nt + 1) * 512);
                    acc[nt] = __builtin_amdgcn_mfma_f32_16x16x32_bf16(ah, bh, acc[nt], 0, 0, 0);
                    acc[nt] = __builtin_amdgcn_mfma_f32_16x16x32_bf16(al, bh, acc[nt], 0, 0, 0);
                    acc[nt] = __builtin_amdgcn_mfma_f32_16x16x32_bf16(ah, bl, acc[nt], 0, 0, 0); } }
            if (ti + 1 < TPW / 16) P7_LOAD(ti + 1);
            __syncthreads();
#pragma unroll
            for (int nt = 0; nt < 3; ++nt)
#pragma unroll
                for (int r = 0; r < 4; ++r) part[(wave * 16 + 4 * fq + r) * 48 + 16 * nt + fr] = acc[nt][r];
            __syncthreads();
            { const int tk = tid >> 5, j = tid & 31;
              float sa = 0.f, sb = 0.f;
#pragma unroll
              for (int w = 0; w < 8; ++w) { sa += part[(w * 16 + tk) * 48 + j]; if (j < 4) sb += part[(w * 16 + tk) * 48 + 32 + j]; }
              logit[tk * 36 + j] = sa + rbias[j]; if (j < 4) logit[tk * 36 + 32 + j] = sb + rbias[32 + j]; }
            __syncthreads();
            if (tid < 16) {
                const int tok = tok0 + 16 * ti + tid; const LAS float* L = logit + tid * 36;
                float lg[4]; int gi = 0;
#pragma unroll
                for (int q = 0; q < 4; ++q) lg[q] = L[q];
                float gm = lg[0];
#pragma unroll
                for (int q = 1; q < 4; ++q) if (lg[q] > gm) { gm = lg[q]; gi = q; }
                float gden = 0.f;
#pragma unroll
                for (int q = 0; q < 4; ++q) gden += __expf(lg[q] - gm);
                const float gp = 1.0f / gden;
                float le[8];
#pragma unroll
                for (int q = 0; q < 8; ++q) le[q] = L[4 + 8 * gi + q];
                int i0 = 0; float m0 = le[0];
#pragma unroll
                for (int q = 1; q < 8; ++q) if (le[q] > m0) { m0 = le[q]; i0 = q; }
                int i1 = -1; float m1 = -INFINITY;
#pragma unroll
                for (int q = 0; q < 8; ++q) if (q != i0 && le[q] > m1) { m1 = le[q]; i1 = q; }
                const float e1 = __expf(m1 - m0), w0 = gp / (1.0f + e1), w1 = gp * e1 / (1.0f + e1);
                const int ea = gi * 8 + i0, eb = gi * 8 + i1;
                const int ra = __hip_atomic_fetch_add(hist + ea, 1, __ATOMIC_RELAXED, __HIP_MEMORY_SCOPE_WORKGROUP), rb = __hip_atomic_fetch_add(hist + eb, 1, __ATOMIC_RELAXED, __HIP_MEMORY_SCOPE_WORKGROUP);
                eidL[2 * (16 * ti + tid)] = ea; eidL[2 * (16 * ti + tid) + 1] = eb; lrL[2 * (16 * ti + tid)] = ra; lrL[2 * (16 * ti + tid) + 1] = rb; WT[2 * tok] = w0; WT[2 * tok + 1] = w1;
            }
        }
#undef P7_LOAD
        __syncthreads();
        LAS int* wbase = (LAS int*)(lds + MISC_OFF + 1536);
        if (tid < 32) wbase[tid] = (int)__hip_atomic_fetch_add(ECNT + tid, (unsigned)hist[tid], __ATOMIC_RELAXED, __HIP_MEMORY_SCOPE_AGENT);
        __syncthreads();
        for (int i = tid; i < 2 * TPW; i += 512) { const int e = eidL[i], pos = wbase[e] + lrL[i]; LIST[(size_t)e * LCAP + pos] = tok0 + (i >> 1); EID[2 * tok0 + i] = e; TOKPOS[2 * tok0 + i] = pos; }
    }
    SEAM(7);

    TSTAMP(8);

    if (IN(9)) {
        build_tiles2(ECNT, lds);
        const LAS int* ttab = (const LAS int*)(lds + MISC_OFF + 256);
        pg8::Gemm g{(const bf16*)HB8, (const bf16*)WGU, DM / 2, DM / 2, LIST, -6, nullptr}; pg8::MoeOrder S; S.init(ttab[0], 8, G, c); S.tile_e = ttab + 1; S.tile_l = (const LAS int*)(lds + XTRA_OFF);
        pg8::EpiSwiglu8 E{ACT, DE};
        pg8::gemm_phase<pg8::EpiSwiglu8, pg8::MoeOrder, false, true, true>(lds, g, S, E);
    }
    SEAM(9);

    if (IN(10)) {
        if (MK_N_LAUNCHES != 1) build_tiles2(ECNT, lds);
        const LAS int* ttab = (const LAS int*)(lds + MISC_OFF + 256);
        pg8::Gemm g{(const bf16*)ACT, (const bf16*)WDN, DE / 2, DE / 2, nullptr, -5, nullptr}; pg8::MoeOrder S; S.init(ttab[0], 8, G, c); S.tile_e = ttab + 1; S.tile_l = (const LAS int*)(lds + XTRA_OFF);
        pg8::EpiPlain8 E{YBUF, DM};
        pg8::gemm_phase<pg8::EpiPlain8, pg8::MoeOrder, false, false, true>(lds, g, S, E);
    }
    SEAM(10);

    if (IN(11)) {
        if (MK_N_LAUNCHES != 1) build_tiles2(ECNT, lds);
        const LAS int* tstart = (const LAS int*)(lds + MISC_OFF + 1536);
        const int RPW = NTOK / NGW, row0 = gw * RPW, b = row0 / SEQ;
        float av[32];
#pragma unroll
        for (int j = 0; j < 4; ++j)
#pragma unroll
            for (int i = 0; i < 8; ++i) { const int ch = 512 * j + 8 * lane + i; av[8 * j + i] = g_post_ffn[ch] * MOD[b * NMOD + 5 * DM + ch]; }
        for (int r = 0; r < RPW; ++r) {
            const int tok = row0 + r; const int p0 = tstart[EID[2 * tok]] * 256 + TOKPOS[2 * tok], p1 = tstart[EID[2 * tok + 1]] * 256 + TOKPOS[2 * tok + 1]; const float w0 = WT[2 * tok], w1 = WT[2 * tok + 1];
            const unsigned char* ya = YBUF + (size_t)p0 * DM; const unsigned char* yb = YBUF + (size_t)p1 * DM; float* o1 = out + (size_t)tok * DM;
            const bf16* xr = X1B + (size_t)tok * DM;
            u32x4 xw[4];
#pragma unroll
            for (int j = 0; j < 4; ++j) xw[j] = __builtin_nontemporal_load((const u32x4*)(xr + 512 * j + 8 * lane));
            float yv[32]; float ss = 0.f;
#pragma unroll
            for (int j = 0; j < 4; ++j) { float f[8], f2[8]; unpack8_fp8(__builtin_nontemporal_load((const u32x2*)(ya + 512 * j + 8 * lane)), f); unpack8_fp8(__builtin_nontemporal_load((const u32x2*)(yb + 512 * j + 8 * lane)), f2);
#pragma unroll
                for (int i = 0; i < 8; ++i) { const float v = w0 * f[i] + w1 * f2[i]; yv[8 * j + i] = v; ss += v * v; } }
            const float rs = __builtin_amdgcn_rsqf(wave_sum(ss) * (1.0f / (64.0f * DM)) + EPS) * 0.125f;
#pragma unroll
            for (int j = 0; j < 4; ++j) { float xf[8]; unpack8(xw[j], xf); f32x4 a, bq;
#pragma unroll
                for (int i = 0; i < 4; ++i) { a[i] = xf[i] + av[8 * j + i] * yv[8 * j + i] * rs; bq[i] = xf[4 + i] + av[8 * j + 4 + i] * yv[8 * j + 4 + i] * rs; }
                __builtin_nontemporal_store(a, (f32x4*)(o1 + 512 * j + 8 * lane)); __builtin_nontemporal_store(bq, (f32x4*)(o1 + 512 * j + 8 * lane + 4)); }
        }
    }
    TSTAMP(11);
    if constexpr (kAnyAmp) { const unsigned long long t0_ = __builtin_amdgcn_s_memrealtime(); while (__builtin_amdgcn_s_memrealtime() - t0_ < t_ext) __builtin_amdgcn_s_sleep(32); }
#undef IN
#undef SEAM
#undef TSTAMP
}

extern "C" void kernel_launch(void* const* d_in, const int* in_sizes, int n_in, void* d_out, int out_size, void* d_ws, size_t ws_size, hipStream_t stream) {
    static int grid = 0;
    if (grid == 0) {
        if (n_in != 22 || in_sizes[0] != NTOK * DM || out_size != NTOK * DM || ws_size < WS_END) { fprintf(stderr, "kernel_launch: unexpected shapes (n_in %d, in0 %d, out %d, ws %zu < %zu?)\n", n_in, n_in > 0 ? in_sizes[0] : -1, out_size, ws_size, (size_t)WS_END); grid = -1; return; }
        int dev = 0, cus = 0, per_cu = 0;
        if (hipGetDevice(&dev) != hipSuccess || hipDeviceGetAttribute(&cus, hipDeviceAttributeMultiprocessorCount, dev) != hipSuccess) { grid = -1; return; }
        if (hipFuncSetAttribute((const void*)fwd_kernel, hipFuncAttributeMaxDynamicSharedMemorySize, LDS_BYTES) != hipSuccess) { fprintf(stderr, "kernel_launch: hipFuncSetAttribute failed\n"); grid = -1; return; }
        if (hipOccupancyMaxActiveBlocksPerMultiprocessor(&per_cu, (const void*)fwd_kernel, NWAVES * 64, LDS_BYTES) != hipSuccess || per_cu < 1) { fprintf(stderr, "kernel_launch: occupancy query says %d\n", per_cu); }
        (void)hipGetLastError();
        grid = cus;
        if (grid != 256) fprintf(stderr, "kernel_launch: %d CUs; this kernel is laid out for 256\n", grid);
        if (NTOK % (grid * NWAVES) != 0) { fprintf(stderr, "kernel_launch: grid %d does not divide the token rows\n", grid); grid = -1; return; }
    }
    if (grid < 0) return;
    if (hipMemsetAsync((char*)d_ws + WS_CTL, 0, CTL_ZERO_BYTES, stream) != hipSuccess) return;
    Args a{};
    for (int i = 0; i < 22; ++i) a.in[i] = (const float*)d_in[i];
    a.out = (float*)d_out; a.ws = (unsigned char*)d_ws;
    if (MK_N_LAUNCHES == 1) { a.ph_lo = 0; a.ph_hi = NPHASE; hipLaunchKernelGGL(fwd_kernel, dim3(grid), dim3(NWAVES * 64), LDS_BYTES, stream, a); }
    else { static const int seq[] = {MK_SEQ}; for (int p : seq) { a.ph_lo = p; a.ph_hi = p + 1; hipLaunchKernelGGL(fwd_kernel, dim3(grid), dim3(NWAVES * 64), LDS_BYTES, stream, a); } }
}
```

```cpp
#include <hip/hip_runtime.h>
#include <cstdio>
#include <cstdint>

#ifndef MK_N_LAUNCHES
#define MK_N_LAUNCHES 1
#endif

#ifndef MK_SEQ
#define MK_SEQ 0, 1, 2, 3, 4, 5, 6, 7, 8, 9, 10, 11
#endif
#ifndef MK_AMP
#define MK_AMP 0, 0, 0, 0, 0, 0, 0, 0, 0, 0, 0, 0
#endif
#define LAS __attribute__((address_space(3)))
#define GAS __attribute__((address_space(1)))
typedef unsigned short bf16;
typedef short bf16x8 __attribute__((ext_vector_type(8)));
typedef short s16x4 __attribute__((ext_vector_type(4)));
typedef float f32x4 __attribute__((ext_vector_type(4)));
typedef float f32x2 __attribute__((ext_vector_type(2)));
typedef float f32x16 __attribute__((ext_vector_type(16)));
typedef unsigned u32x4 __attribute__((ext_vector_type(4)));
typedef unsigned u32x2 __attribute__((ext_vector_type(2)));
typedef __bf16 bf16x2_t __attribute__((ext_vector_type(2)));
typedef short v4i16_t __attribute__((ext_vector_type(4)));
typedef int v8i32_t __attribute__((ext_vector_type(8)));
typedef int v8i32_a16 __attribute__((ext_vector_type(8), aligned(16)));

constexpr int NB = 4, SEQ = 8192, NTOK = NB * SEQ, DM = 2048, DIN = 5120, DG = 1024, NE = 32, DE = 1024;
constexpr int NMOD = 6 * DM;
constexpr int PP = 2048;
constexpr float EPS = 1e-6f;
constexpr int PMAX = 73728;
constexpr int TMAX = PMAX / 256;
constexpr float QSCALE = 0.12751743f;

__device__ __forceinline__ unsigned cvtpk(float lo, float hi) { f32x2 v = {lo, hi}; bf16x2_t b = __builtin_convertvector(v, bf16x2_t); return __builtin_bit_cast(unsigned, b); }
__device__ __forceinline__ unsigned cvt4_fp8(float a, float b, float c, float d) { int w = 0; w = __builtin_amdgcn_cvt_pk_fp8_f32(a, b, w, false); w = __builtin_amdgcn_cvt_pk_fp8_f32(c, d, w, true); return (unsigned)w; }
__device__ __forceinline__ void unpack8_fp8(const u32x2 w, float (&f)[8]) { const f32x2 a = __builtin_amdgcn_cvt_pk_f32_fp8((int)w.x, false), b = __builtin_amdgcn_cvt_pk_f32_fp8((int)w.x, true), c = __builtin_amdgcn_cvt_pk_f32_fp8((int)w.y, false), d = __builtin_amdgcn_cvt_pk_f32_fp8((int)w.y, true);
    f[0] = a[0]; f[1] = a[1]; f[2] = b[0]; f[3] = b[1]; f[4] = c[0]; f[5] = c[1]; f[6] = d[0]; f[7] = d[1]; }
__device__ __forceinline__ float bflo(unsigned w) { return __uint_as_float(w << 16); }
__device__ __forceinline__ float bfhi(unsigned w) { return __uint_as_float(w & 0xffff0000u); }
__device__ __forceinline__ float wave_sum(float v) {
#pragma unroll
    for (int o = 1; o < 64; o <<= 1) v += __shfl_xor(v, o);
    return v;
}
__device__ __forceinline__ float gelu_t(float v) { const float u = v * (1.0f + 0.044715f * v * v); const float e = __builtin_amdgcn_exp2f(-2.302208198f * u); return v * __builtin_amdgcn_rcpf(1.0f + e); }
__device__ __forceinline__ float silu_f(float v) { return v * __builtin_amdgcn_rcpf(1.0f + __builtin_amdgcn_exp2f(-1.442695041f * v)); }

namespace pg8 {
constexpr int BM = 256, BK = 64, HALF = 128, HTB = HALF * BK * 2, STAGE_BYTES = 8 * HTB, NXCD = 8, WGM = 8;
__host__ __device__ __forceinline__ int lds_byte(int r, int c) { const int st = (r >> 4) * 2 + (c >> 5), rr = r & 15, cc = c & 31, ob = rr * 64 + cc * 2; return st * 1024 + (ob ^ (((ob >> 9) & 1) << 5)); }
__host__ __device__ __forceinline__ void stage_rc(int b, int& R, int& C) { const int st = b / 1024, sb = b % 1024, swz = sb ^ (((sb >> 9) & 1) << 5); R = (st >> 1) * 16 + swz / 64; C = (st & 1) * 32 + (swz % 64) / 2; }
__host__ __device__ __forceinline__ int perm32(int rho) { const int n = rho >> 4, i = rho & 15; return 8 * (i >> 2) + 4 * n + (i & 3); }

struct Unit { int pm, pn; };
struct Gemm { const bf16* A; const bf16* Bt; int K; int lda; const int* arow; int sexp; const float* rss; };

struct StaticOrder {
    int nM, nN, nwg, G, c, i0, i1;
    __device__ void init(int nM_, int nN_, int G_, int c_) { nM = nM_; nN = nN_; nwg = nM * nN; G = G_; c = c_; i0 = 0; i1 = 0x7fffffff; }
    __device__ bool next(int i, Unit& u) const {
        i += i0; if (i >= i1) return false;
        const long L = (long)i * G + c; if (L >= nwg) return false;
        int wgid = (int)L; { const int q = nwg / NXCD, r = nwg % NXCD, xcd = wgid % NXCD, off = wgid / NXCD; wgid = (xcd < r ? xcd * (q + 1) : r * (q + 1) + (xcd - r) * q) + off; }
        const int nig = WGM * nN, gid = wgid / nig, fm = gid * WGM, gsz = (nM - fm) < WGM ? (nM - fm) : WGM;
        u.pm = fm + ((wgid % nig) % gsz); u.pn = (wgid % nig) / gsz; return true;
    }
    __device__ __forceinline__ int bidx(const Unit& u) const { return u.pn; }
    __device__ __forceinline__ int aoff(int pm) const { return pm * BM; }
};
struct MoeOrder : StaticOrder {
    const LAS int* tile_e; const LAS int* tile_l;
    __device__ __forceinline__ int bidx(const Unit& u) const { return tile_e[u.pm] * nN + u.pn; }
    __device__ __forceinline__ int aoff(int pm) const { return tile_l[pm]; }
};

struct EpiInProj {
    static constexpr bool PERM = true;
    bf16* O; int ldc; bf16* QKV; float* VST;
    __device__ __forceinline__ void operator()(const f32x4 (&acc)[2][2][4][2], const Unit& u, int wr, int wc, int fr, int fq) const {
        const int row0 = u.pm * BM + wr * 64 + fr;
        if (u.pn < 8) {
            const int col0 = u.pn * BM + wc * 32 + 8 * fq;
#pragma unroll
            for (int ai = 0; ai < 2; ++ai)
#pragma unroll
                for (int m = 0; m < 4; ++m) { bf16* rowp = O + (size_t)(row0 + ai * HALF + m * 16) * ldc + col0; float s1 = 0.f, s2 = 0.f;
#pragma unroll
                    for (int bj = 0; bj < 2; ++bj) { f32x4 v0 = acc[ai][bj][m][0], v1 = acc[ai][bj][m][1];
#pragma unroll
                        for (int j = 0; j < 4; ++j) { v0[j] = gelu_t(v0[j]); v1[j] = gelu_t(v1[j]); }
                        u32x4 w; w.x = cvtpk(v0[0], v0[1]); w.y = cvtpk(v0[2], v0[3]); w.z = cvtpk(v1[0], v1[1]); w.w = cvtpk(v1[2], v1[3]);
                        *(u32x4*)(rowp + bj * HALF) = w;
                        if (u.pn >= 4) {
#pragma unroll
                            for (int j = 0; j < 4; ++j) { const float a = bflo(w[j]), b = bfhi(w[j]); s1 += a + b; s2 += a * a + b * b; } } }
                    if (u.pn >= 4) { s1 += __shfl_xor(s1, 16); s2 += __shfl_xor(s2, 16); s1 += __shfl_xor(s1, 32); s2 += __shfl_xor(s2, 32);
                        if (fq == 0) *(f32x2*)(VST + ((size_t)(row0 + ai * HALF + m * 16) * 16 + (u.pn - 4) * 4 + wc) * 2) = (f32x2){s1, s2}; } }
        } else {
            const int which = (u.pn - 8) >> 2, hp = (u.pn - 8) & 3; const float sc = which == 0 ? QSCALE : 1.0f;
            bf16* base = QKV + (size_t)which * NTOK * 1024 + wc * 32 + 8 * fq;
#pragma unroll
            for (int ai = 0; ai < 2; ++ai)
#pragma unroll
                for (int m = 0; m < 4; ++m) { const int r = row0 + ai * HALF + m * 16, bb = r >> 13, sq = r & (SEQ - 1);
#pragma unroll
                    for (int bj = 0; bj < 2; ++bj) { const f32x4 v0 = acc[ai][bj][m][0] * sc, v1 = acc[ai][bj][m][1] * sc;
                        u32x4 w; w.x = cvtpk(v0[0], v0[1]); w.y = cvtpk(v0[2], v0[3]); w.z = cvtpk(v1[0], v1[1]); w.w = cvtpk(v1[2], v1[3]);
                        *(u32x4*)(base + ((size_t)(bb * 8 + 2 * hp + bj) * SEQ + sq) * 128) = w; } }
        }
    }
};
struct EpiPlain8 {
    static constexpr bool PERM = true;
    unsigned char* O; int ldc;
    __device__ __forceinline__ void operator()(const f32x4 (&acc)[2][2][4][2], const Unit& u, int wr, int wc, int fr, int fq) const {
        const int row0 = u.pm * BM + wr * 64 + fr + 16 * (fq & 1), col0 = u.pn * BM + wc * 32 + 8 * (fq & 2);
#pragma unroll
        for (int ai = 0; ai < 2; ++ai)
#pragma unroll
            for (int mp = 0; mp < 2; ++mp) { unsigned char* rowp = O + (size_t)(row0 + ai * HALF + mp * 32) * ldc + col0;
#pragma unroll
                for (int bj = 0; bj < 2; ++bj) { const f32x4 a0 = acc[ai][bj][2 * mp][0], a1 = acc[ai][bj][2 * mp][1], b0 = acc[ai][bj][2 * mp + 1][0], b1 = acc[ai][bj][2 * mp + 1][1];
                    const u32x2 sx = __builtin_amdgcn_permlane16_swap(cvt4_fp8(a0[0], a0[1], a0[2], a0[3]), cvt4_fp8(b0[0], b0[1], b0[2], b0[3]), false, false);
                    const u32x2 sy = __builtin_amdgcn_permlane16_swap(cvt4_fp8(a1[0], a1[1], a1[2], a1[3]), cvt4_fp8(b1[0], b1[1], b1[2], b1[3]), false, false);
                    *(u32x4*)(rowp + bj * HALF) = (u32x4){sx[0], sy[0], sx[1], sy[1]}; } }
    }
};
struct EpiSwiglu8 {
    static constexpr bool PERM = true;
    unsigned char* O; int ldc;
    __device__ __forceinline__ void operator()(const f32x4 (&acc)[2][2][4][2], const Unit& u, int wr, int wc, int fr, int fq) const {
        const int row0 = u.pm * BM + wr * 64 + fr, col0 = u.pn * HALF + wc * 32 + 8 * fq;
#pragma unroll
        for (int ai = 0; ai < 2; ++ai)
#pragma unroll
            for (int m = 0; m < 4; ++m) { unsigned char* rowp = O + (size_t)(row0 + ai * HALF + m * 16) * ldc + col0;
                f32x4 v0, v1;
#pragma unroll
                for (int j = 0; j < 4; ++j) { v0[j] = silu_f(acc[ai][0][m][0][j]) * acc[ai][1][m][0][j] * 4.0f; v1[j] = silu_f(acc[ai][0][m][1][j]) * acc[ai][1][m][1][j] * 4.0f; }
                u32x2 w; w.x = cvt4_fp8(v0[0], v0[1], v0[2], v0[3]); w.y = cvt4_fp8(v1[0], v1[1], v1[2], v1[3]);
                *(u32x2*)rowp = w; }
    }
};
template <bool FP8> struct Frag { bf16x8 v[2]; };
template <> struct Frag<true> { v8i32_t v; };
template <class Epi, class Sched, bool ALIGN_EPI, bool GATHER, bool FP8 = false, int MIDK = 0>
__device__ __forceinline__ void gemm_phase(LAS unsigned char* lds, const Gemm g, const Sched& S, const Epi& E) {
    const int tid = threadIdx.x, wid = __builtin_amdgcn_readfirstlane(tid >> 6), lane = tid & 63, wr = wid >> 2, wc = wid & 3, fr = lane & 15, fq = lane >> 4;
    const int K = g.K, nt = K / BK, lda = g.lda;
    unsigned voffB[2]; int RA[2], CA[2];
    unsigned oc[2][2], on[2][2];
#pragma unroll
    for (int i = 0; i < 2; ++i) { int R, C; stage_rc(tid * 16 + i * 8192, R, C); const int Rb = Epi::PERM ? ((R & ~31) + perm32(R & 31)) : R;
        RA[i] = R; CA[i] = C; voffB[i] = (unsigned)(Rb * K + C) * 2u; }
    const size_t kstep = (size_t)(BK * 2);
    const size_t hstepB = (size_t)HALF * K * 2, tstepB = 2 * hstepB;
    const size_t tstepA = (size_t)BM * lda * 2;
    const unsigned ldsw = (unsigned)wid * 1024u;
    const int aoff = lds_byte(wr * 64 + fr, fq * 8), boff = lds_byte(wc * 32 + fr, fq * 8);
#define PG8_SA(b, h) (((b) * 2 + (h)) * HTB)
#define PG8_SB(b, h) ((4 + (b) * 2 + (h)) * HTB)
#define PG8_STAGE(bufoff, gbase, voff) do { _Pragma("unroll") for (int _i = 0; _i < 2; ++_i) \
        __builtin_amdgcn_global_load_lds((const unsigned*)((const char*)(gbase) + (voff)[_i]), (LAS unsigned*)(lds + (bufoff) + ldsw + _i * 8192), 16, 0, 0); } while (0)
#define PG8_LDA(dst, b, h) do { _Pragma("unroll") for (int m = 0; m < 4; ++m) { \
        if constexpr (FP8) dst[m].v = __builtin_bit_cast(v8i32_t, __builtin_shufflevector(*(const LAS bf16x8*)(lds + PG8_SA(b, h) + aoff + m * 2048), *(const LAS bf16x8*)(lds + PG8_SA(b, h) + aoff + m * 2048 + 1024), 0, 1, 2, 3, 4, 5, 6, 7, 8, 9, 10, 11, 12, 13, 14, 15)); \
        else { _Pragma("unroll") for (int k = 0; k < 2; ++k) dst[m].v[k] = *(const LAS bf16x8*)(lds + PG8_SA(b, h) + aoff + m * 2048 + k * 1024); } } } while (0)
#define PG8_LDB(dst, b, h) do { _Pragma("unroll") for (int n = 0; n < 2; ++n) { \
        if constexpr (FP8) dst[n].v = __builtin_bit_cast(v8i32_t, __builtin_shufflevector(*(const LAS bf16x8*)(lds + PG8_SB(b, h) + boff + n * 2048), *(const LAS bf16x8*)(lds + PG8_SB(b, h) + boff + n * 2048 + 1024), 0, 1, 2, 3, 4, 5, 6, 7, 8, 9, 10, 11, 12, 13, 14, 15)); \
        else { _Pragma("unroll") for (int k = 0; k < 2; ++k) dst[n].v[k] = *(const LAS bf16x8*)(lds + PG8_SB(b, h) + boff + n * 2048 + k * 1024); } } } while (0)
#define PG8_MMA(ai, bj, At, Bt) do { __builtin_amdgcn_s_setprio(1); _Pragma("unroll") for (int m = 0; m < 4; ++m) _Pragma("unroll") for (int n = 0; n < 2; ++n) { \
        if constexpr (FP8) asm volatile("v_mfma_scale_f32_16x16x128_f8f6f4 %0, %1, %2, %0, %3, %4 op_sel_hi:[0,0,0]" : "+v"(acc[ai][bj][m][n]) : "v"(Bt[n].v), "v"(At[m].v), "v"(sc1), "v"(sc2));   \
        else { _Pragma("unroll") for (int k = 0; k < 2; ++k) acc[ai][bj][m][n] = __builtin_amdgcn_mfma_f32_16x16x32_bf16(Bt[n].v[k], At[m].v[k], acc[ai][bj][m][n], 0, 0, 0); } } \
        __builtin_amdgcn_s_setprio(0); } while (0)
#define PG8_WAIT_V(n) asm volatile("s_waitcnt vmcnt(" #n ")" ::: "memory")
#define PG8_WAIT_L(n) asm volatile("s_waitcnt lgkmcnt(" #n ")" ::: "memory")
#define PG8_BAR __builtin_amdgcn_s_barrier()
#define PG8_SCHED __builtin_amdgcn_sched_barrier(0)
#define PG8_AOFF(dst, pm_) do { _Pragma("unroll") for (int _h = 0; _h < 2; ++_h) _Pragma("unroll") for (int _i = 0; _i < 2; ++_i) { \
        if constexpr (GATHER) { unsigned r_ = (unsigned)g.arow[S.aoff(pm_) + _h * HALF + RA[_i]]; r_ = r_ < (unsigned)NTOK ? r_ : 0u;     \
            dst[_h][_i] = (r_ * (unsigned)lda + (unsigned)CA[_i]) * 2u; } \
        else dst[_h][_i] = ((unsigned)(_h * HALF + RA[_i]) * (unsigned)lda + (unsigned)CA[_i]) * 2u; } } while (0)
    Unit cur, nxt; int ui = 0;
    if (!S.next(0, cur)) return;
    f32x4 acc[2][2][4][2];
#pragma unroll
    for (int a = 0; a < 2; ++a)
#pragma unroll
        for (int b = 0; b < 2; ++b)
#pragma unroll
            for (int m = 0; m < 4; ++m)
#pragma unroll
                for (int n = 0; n < 2; ++n) acc[a][b][m][n] = (f32x4){0.f, 0.f, 0.f, 0.f};
    Frag<FP8> At[4], B0[2], B1[2];
    LAS float* rtab = (LAS float*)(lds + STAGE_BYTES);
    float rnext = 0.f;
    const int sc1 = 0x7f7f7f7f, sc2 = 0x01010101 * (127 + g.sexp);
    PG8_AOFF(oc, cur.pm);
    if constexpr (MIDK != 0) { if (tid < BM) rtab[tid] = __builtin_amdgcn_rsqf(g.rss[cur.pm * BM + tid] * (1.0f / 1024.0f) + EPS); }
    const char* cA = (const char*)g.A + (GATHER ? (size_t)0 : (size_t)cur.pm * tstepA); const char* cB = (const char*)g.Bt + (size_t)S.bidx(cur) * tstepB;
    PG8_STAGE(PG8_SB(0, 0), cB, voffB); PG8_STAGE(PG8_SB(0, 1), cB + hstepB, voffB); PG8_STAGE(PG8_SA(0, 0), cA, oc[0]); PG8_STAGE(PG8_SA(0, 1), cA, oc[1]);
    if (wr == 1) PG8_BAR;
    PG8_WAIT_V(2); PG8_BAR;
    PG8_STAGE(PG8_SB(1, 0), cB + kstep, voffB); PG8_STAGE(PG8_SA(1, 0), cA + kstep, oc[0]); PG8_STAGE(PG8_SB(1, 1), cB + hstepB + kstep, voffB);
    PG8_WAIT_V(6); PG8_BAR;
    for (;;) {
        const bool has_next = S.next(ui + 1, nxt);
        const char* nA = cA; const char* nB = cB;
        if (has_next) { nA = (const char*)g.A + (GATHER ? (size_t)0 : (size_t)nxt.pm * tstepA); nB = (const char*)g.Bt + (size_t)S.bidx(nxt) * tstepB; PG8_AOFF(on, nxt.pm);
            if constexpr (MIDK != 0) { if (tid < BM) rnext = g.rss[nxt.pm * BM + tid]; } }
        else {
#pragma unroll
            for (int h = 0; h < 2; ++h)
#pragma unroll
                for (int i = 0; i < 2; ++i) on[h][i] = oc[h][i]; }
        for (int t = 0; t < nt; t += 2) {
            const bool last = (t == nt - 2);
            const char* a1 = cA + (size_t)(t + 1) * kstep;
            const char* a2 = last ? nA : cA + (size_t)(t + 2) * kstep; const char* b2 = last ? nB : cB + (size_t)(t + 2) * kstep;
            const char* a3 = a2 + kstep; const char* b3 = b2 + kstep;
            unsigned o2[2][2];
#pragma unroll
            for (int h = 0; h < 2; ++h)
#pragma unroll
                for (int i = 0; i < 2; ++i) o2[h][i] = last ? on[h][i] : oc[h][i];
            PG8_LDB(B0, 0, 0); PG8_LDB(B1, 0, 1); PG8_SCHED; PG8_LDA(At, 0, 0); PG8_STAGE(PG8_SA(1, 1), a1, oc[1]);
            if constexpr (MIDK != 0) { if (t == MIDK) {
#pragma unroll
                for (int a = 0; a < 2; ++a)
#pragma unroll
                    for (int b = 0; b < 2; ++b)
#pragma unroll
                        for (int m = 0; m < 4; ++m)
#pragma unroll
                            for (int n = 0; n < 2; ++n) acc[a][b][m][n] *= rtab[a * HALF + wr * 64 + m * 16 + fr];
            } }
            PG8_WAIT_V(8); PG8_WAIT_L(0); PG8_BAR; PG8_MMA(0, 0, At, B0); PG8_MMA(0, 1, At, B1); PG8_BAR; PG8_SCHED;
            PG8_LDA(At, 0, 1); PG8_STAGE(PG8_SB(0, 0), b2, voffB); PG8_STAGE(PG8_SB(0, 1), b2 + hstepB, voffB); PG8_STAGE(PG8_SA(0, 0), a2, o2[0]);
            PG8_WAIT_V(8); PG8_WAIT_L(0); PG8_BAR; PG8_MMA(1, 0, At, B0); PG8_MMA(1, 1, At, B1); PG8_BAR; PG8_SCHED;
            PG8_LDB(B0, 1, 0); PG8_LDB(B1, 1, 1); PG8_SCHED; PG8_LDA(At, 1, 0); PG8_STAGE(PG8_SA(0, 1), a2, o2[1]);
            PG8_WAIT_V(8); PG8_WAIT_L(0); PG8_BAR; PG8_MMA(0, 0, At, B0); PG8_MMA(0, 1, At, B1); PG8_BAR; PG8_SCHED;
            PG8_LDA(At, 1, 1); PG8_STAGE(PG8_SB(1, 0), b3, voffB); PG8_STAGE(PG8_SB(1, 1), b3 + hstepB, voffB); PG8_STAGE(PG8_SA(1, 0), a3, o2[0]);
            PG8_WAIT_V(8); PG8_WAIT_L(0); PG8_BAR; PG8_MMA(1, 0, At, B0); PG8_MMA(1, 1, At, B1); PG8_BAR; PG8_SCHED;
        }
        if constexpr (FP8) asm volatile("s_nop 15\n\ts_nop 15" ::: "memory");
        if constexpr (ALIGN_EPI) { if (wr == 0) PG8_BAR; }
        E(acc, cur, wr, wc, fr, fq);
        if (!has_next) break;
#pragma unroll
        for (int a = 0; a < 2; ++a)
#pragma unroll
            for (int b = 0; b < 2; ++b)
#pragma unroll
                for (int m = 0; m < 4; ++m)
#pragma unroll
                    for (int n = 0; n < 2; ++n) acc[a][b][m][n] = (f32x4){0.f, 0.f, 0.f, 0.f};
        cur = nxt; cA = nA; cB = nB; ++ui;
        if constexpr (MIDK != 0) { if (tid < BM) rtab[tid] = __builtin_amdgcn_rsqf(rnext * (1.0f / 1024.0f) + EPS); }
#pragma unroll
        for (int h = 0; h < 2; ++h)
#pragma unroll
            for (int i = 0; i < 2; ++i) oc[h][i] = on[h][i];
        if constexpr (ALIGN_EPI) { if (wr == 1) PG8_BAR; }
    }
    PG8_WAIT_V(0);
    if constexpr (!ALIGN_EPI) { if (wr == 0) PG8_BAR; }
    PG8_BAR;
#undef PG8_SA
#undef PG8_SB
#undef PG8_STAGE
#undef PG8_LDA
#undef PG8_LDB
#undef PG8_MMA
#undef PG8_WAIT_V
#undef PG8_WAIT_L
#undef PG8_BAR
#undef PG8_SCHED
#undef PG8_AOFF
}
}

constexpr size_t MiB = 1u << 20;
constexpr size_t WS_CTL = 0, CTL_ZERO_BYTES = 65536;
constexpr size_t WS_ROWTOK = 65536;
constexpr size_t WS_MOD = 1 * MiB;
constexpr size_t WS_WSM = 1 * MiB + 256 * 1024;
constexpr size_t WS_YASS = 1 * MiB + 512 * 1024;
constexpr size_t WS_EID = 1 * MiB + 768 * 1024;
constexpr size_t WS_LRANK = 2 * MiB;
constexpr size_t WS_WT = 2 * MiB + 256 * 1024;
constexpr size_t WS_TOKPOS = 2 * MiB + 512 * 1024;
constexpr size_t WS_LCNT = 2 * MiB + 768 * 1024;
constexpr size_t WS_LIST = 600 * MiB; constexpr int LCAP = 65536;
constexpr int CW_MODC = 8256;
constexpr int CW_ECNT = 8192;
constexpr size_t WS_ML = 3 * MiB;
constexpr size_t WS_WRF = 9 * MiB;
constexpr size_t WS_WIN = 10 * MiB;
constexpr size_t WS_WOUT = 30 * MiB;
constexpr size_t WS_WGU = 38 * MiB;
constexpr size_t WS_WDN = 166 * MiB;
constexpr size_t WS_HB = 230 * MiB;
constexpr size_t WS_PROJ = 358 * MiB;
constexpr size_t WS_QKV = 486 * MiB;
constexpr size_t WS_OPART = 678 * MiB;
constexpr size_t WS_Y1 = 870 * MiB;
constexpr size_t WS_ACT = 358 * MiB;
constexpr size_t WS_YBUF = 430 * MiB;
constexpr size_t WS_END = 998 * MiB;
static_assert(WS_ACT + (size_t)PMAX * DE <= WS_YBUF && WS_YBUF + (size_t)PMAX * DM <= WS_Y1 && WS_OPART + (size_t)3 * NTOK * 1024 * 2 <= WS_Y1 && WS_WDN + (size_t)NE * DM * DE <= WS_HB, "d_ws map");
constexpr int CW_BAR = 4096, XCD_BAR_WORDS_C = 3456;
static_assert((size_t)(CW_MODC + 64) * 4 <= CTL_ZERO_BYTES && (size_t)(CW_BAR + XCD_BAR_WORDS_C) * 4 <= (size_t)CW_ECNT * 4, "control words inside the memset region");

constexpr int RING_BYTES = 155648;
constexpr int MISC_OFF = RING_BYTES;
constexpr int XTRA_OFF = MISC_OFF + 2048;
constexpr int LDS_BYTES = 163840;
constexpr int NWAVES = 8;
constexpr int NPHASE = 12;
constexpr int kAmp[NPHASE] = {MK_AMP};
constexpr bool kAnyAmp = (kAmp[0] | kAmp[1] | kAmp[2] | kAmp[3] | kAmp[4] | kAmp[5] | kAmp[6] | kAmp[7] | kAmp[8] | kAmp[9] | kAmp[10] | kAmp[11]) != 0;

#define RLX_AGENT __ATOMIC_RELAXED, __HIP_MEMORY_SCOPE_AGENT
#define XB_TMO      128
#define XB_XCNT(j)  (256  + 64 * (j))
#define XB_XSUB(j)  (1280 + 64 * (j))
#define XB_XGEN(j)  (2304 + 64 * (j))
#define XB_TOP      3328
#define XB_TOPGEN   3392
#define XCD_BAR_WORDS 3456
#define XB_SPIN_CAP (1u << 18)
__device__ __forceinline__ unsigned xb_ld(unsigned* p)              { return __hip_atomic_load(p, __ATOMIC_RELAXED, __HIP_MEMORY_SCOPE_AGENT); }
__device__ __forceinline__ unsigned xb_add(unsigned* p, unsigned v) { return __hip_atomic_fetch_add(p, v, __ATOMIC_RELAXED, __HIP_MEMORY_SCOPE_AGENT); }
__device__ __forceinline__ unsigned xb_xcc_id() { return (unsigned)__builtin_amdgcn_s_getreg((3 << 11) | 20) & 0xFu; }
#define XB_SPIN(cond, bar) do { unsigned _sp = 0; while (cond) { __builtin_amdgcn_s_sleep(1); \
    if ((++_sp & 255u) == 0u) { if (xb_ld(&(bar)[XB_TMO])) break; if (_sp > XB_SPIN_CAP) { atomicAdd(&(bar)[XB_TMO], 1u); break; } } } } while (0)
struct XcdBarrier { unsigned* bar; unsigned x; volatile LAS unsigned* st; };
__device__ __forceinline__ XcdBarrier xcd_barrier_post(unsigned* bar, volatile LAS unsigned* st) {
    XcdBarrier b; b.bar = bar; b.x = xb_xcc_id(); b.st = st;
    if (threadIdx.x == 0) (void)xb_add(&bar[XB_XCNT(b.x)], 1u);
    return b;
}
__device__ __forceinline__ void xcd_barrier_complete(unsigned* bar, unsigned x, unsigned& nloc, unsigned& nx) {
    const unsigned G = gridDim.x * gridDim.y * gridDim.z;
    unsigned sum, cnt, mine, sp = 0u;
    for (;;) {
        sum = 0u; cnt = 0u; mine = 0u;
#pragma unroll
        for (unsigned j = 0; j < 16; ++j) { const unsigned c = xb_ld(&bar[XB_XCNT(j)]); sum += c; cnt += (c > 0u) ? 1u : 0u; mine = (j == x) ? c : mine; }
        if (sum == G) break;
        __builtin_amdgcn_s_sleep(1);
        if ((++sp & 255u) == 0u) { if (xb_ld(&bar[XB_TMO])) break; if (sp > XB_SPIN_CAP) { atomicAdd(&bar[XB_TMO], 1u); break; } }
    }
    nloc = mine > 0u ? mine : 1u; nx = cnt > 0u ? cnt : 1u;
}
__device__ __forceinline__ void xcd_barrier(const XcdBarrier& b) {
    asm volatile("s_waitcnt vmcnt(0)" ::: "memory");
    __syncthreads();
    if (threadIdx.x == 0) {
        unsigned* bar = b.bar;
        __builtin_amdgcn_s_waitcnt(0);
        unsigned nloc = b.st[0], nx = b.st[1];
        if (nloc == 0u) { xcd_barrier_complete(bar, b.x, nloc, nx); b.st[0] = nloc; b.st[1] = nx; }
        const unsigned old = xb_add(&bar[XB_XSUB(b.x)], 1u);
        const unsigned gen = old / nloc;
        if (old + 1u == (gen + 1u) * nloc) {
            __builtin_amdgcn_fence(__ATOMIC_RELEASE, "agent");
            asm volatile("s_waitcnt vmcnt(0)" ::: "memory");
            const unsigned og = xb_add(&bar[XB_TOP], 1u);
            const unsigned tg = og / nx;
            if (og + 1u == (tg + 1u) * nx) {
#pragma unroll
                for (unsigned j = 0; j < 16; ++j) (void)xb_add(&bar[XB_XGEN(j)], 1u);
            } else XB_SPIN(xb_ld(&bar[XB_XGEN(b.x)]) == gen, bar);
            __builtin_amdgcn_fence(__ATOMIC_ACQUIRE, "agent");
            asm volatile("s_waitcnt vmcnt(0)" ::: "memory");
        } else {
            XB_SPIN(xb_ld(&bar[XB_XGEN(b.x)]) == gen, bar);
            __builtin_amdgcn_fence(__ATOMIC_ACQUIRE, "agent");
            asm volatile("s_waitcnt vmcnt(0)" ::: "memory");
        }
    }
    __syncthreads();
}

__device__ __forceinline__ s16x4 vtr(const LAS unsigned char* p) { return __builtin_bit_cast(s16x4, __builtin_amdgcn_ds_read_tr16_b64_v4i16((LAS v4i16_t*)p)); }
#define MFMA32(a, b, c) __builtin_amdgcn_mfma_f32_32x32x16_bf16((a), (b), (c), 0, 0, 0)
__device__ __forceinline__ int crow(int r, int hi) { return (r & 3) + 8 * (r >> 2) + 4 * hi; }
__device__ __forceinline__ void unpack8(const u32x4 w, float (&f)[8]) { f[0] = bflo(w.x); f[1] = bfhi(w.x); f[2] = bflo(w.y); f[3] = bfhi(w.y); f[4] = bflo(w.z); f[5] = bfhi(w.z); f[6] = bflo(w.w); f[7] = bfhi(w.w); }
__device__ __forceinline__ u32x4 pack8(const float (&f)[8]) { u32x4 w; w.x = cvtpk(f[0], f[1]); w.y = cvtpk(f[2], f[3]); w.z = cvtpk(f[4], f[5]); w.w = cvtpk(f[6], f[7]); return w; }

struct Args { const float* in[22]; float* out; unsigned char* ws; int ph_lo, ph_hi; };

__device__ __forceinline__ void transpose_item8(const float* W, int N, int k0, int n0, unsigned char* dst, int ldk, LAS float* scr, int lane) {
    const int cl = lane & 7, kq = lane >> 3;
#pragma unroll 4
    for (int i = 0; i < 16; ++i) { const int kk = 8 * i + kq; const f32x4 v = __builtin_nontemporal_load((const f32x4*)(W + (size_t)(k0 + kk) * N + n0 + 4 * cl));
        LAS float* s = scr + kk * 33 + 4 * cl; s[0] = v[0]; s[1] = v[1]; s[2] = v[2]; s[3] = v[3]; }
    asm volatile("s_waitcnt lgkmcnt(0)" ::: "memory");
    const int c = lane >> 4, nn = lane & 15;
#pragma unroll
    for (int it = 0; it < 2; ++it)
#pragma unroll
        for (int hh = 0; hh < 2; ++hh) { const int n = nn + 16 * it, kc = 16 * (c + 4 * hh); const LAS float* s = scr + kc * 33 + n; u32x4 o;
            o.x = cvt4_fp8(64.f * s[0], 64.f * s[33], 64.f * s[2 * 33], 64.f * s[3 * 33]); o.y = cvt4_fp8(64.f * s[4 * 33], 64.f * s[5 * 33], 64.f * s[6 * 33], 64.f * s[7 * 33]);
            o.z = cvt4_fp8(64.f * s[8 * 33], 64.f * s[9 * 33], 64.f * s[10 * 33], 64.f * s[11 * 33]); o.w = cvt4_fp8(64.f * s[12 * 33], 64.f * s[13 * 33], 64.f * s[14 * 33], 64.f * s[15 * 33]);
            __builtin_nontemporal_store(o, (u32x4*)(dst + (size_t)n * ldk + k0 + kc)); }
    asm volatile("s_waitcnt lgkmcnt(0)" ::: "memory");
}

__device__ __forceinline__ void build_tiles(const int* lcnt, int G, int c, LAS unsigned char* lds, bool want_base) {
    LAS int* tot = (LAS int*)(lds + MISC_OFF + 1792); LAS int* wof = tot + 32;
    LAS int* ttab = (LAS int*)(lds + MISC_OFF + 256); LAS int* base = (LAS int*)(lds + MISC_OFF + 1536);
    const int tid = threadIdx.x;
    LAS int* ptot = (LAS int*)lds; LAS int* pbef = ptot + 512;
    { const int e = tid & 31, sl = tid >> 5; int t = 0, b = 0;
      for (int w = sl; w < G; w += 16) { const int v = lcnt[w * 32 + e]; t += v; b += (w < c) ? v : 0; }
      ptot[sl * 32 + e] = t; pbef[sl * 32 + e] = b; }
    __syncthreads();
    if (tid < 32) { int t = 0, b = 0;
#pragma unroll
        for (int sl = 0; sl < 16; ++sl) { t += ptot[sl * 32 + tid]; b += pbef[sl * 32 + tid]; }
        tot[tid] = t; wof[tid] = b; }
    __syncthreads();
    if (tid == 0) { int ts = 0; for (int e = 0; e < 32; ++e) { const int nt = (tot[e] + 255) >> 8; for (int j = 0; j < nt; ++j) ttab[1 + ts + j] = e; if (want_base) base[e] = ts * 256 + wof[e]; ts += nt; } ttab[0] = ts; }
    __syncthreads();
}

__device__ __forceinline__ void build_tiles2(const unsigned* ecnt, LAS unsigned char* lds) {
    LAS int* ttab = (LAS int*)(lds + MISC_OFF + 256); LAS int* tstart = (LAS int*)(lds + MISC_OFF + 1536); LAS int* tile_l = (LAS int*)(lds + XTRA_OFF);
    if (threadIdx.x < 64) { const int e = threadIdx.x & 31; const int cnt = (int)ecnt[e], nt = (cnt + 255) >> 8; int ts = nt;
#pragma unroll
        for (int o = 1; o < 32; o <<= 1) { const int v = __shfl_up(ts, o, 32); if (e >= o) ts += v; }
        const int first = ts - nt;
        if (threadIdx.x < 32) { tstart[e] = first; for (int j = 0; j < nt; ++j) { ttab[1 + first + j] = e; tile_l[first + j] = e * LCAP + j * 256; } if (e == 31) ttab[0] = ts; } }
    __syncthreads();
}

__global__ void __launch_bounds__(NWAVES * 64, 2) fwd_kernel(Args args) {
    extern __shared__ __attribute__((aligned(16))) unsigned char lds_raw[];
    LAS unsigned char* lds = (LAS unsigned char*)lds_raw;
    const int tid = threadIdx.x, lane = tid & 63, wave = __builtin_amdgcn_readfirstlane(tid >> 6);
    const int G = gridDim.x, c = blockIdx.x;
    const int gw = c * NWAVES + wave, NGW = G * NWAVES;
    unsigned char* ws = args.ws;
    unsigned* ctl = (unsigned*)(ws + WS_CTL);
    const float* x = args.in[0]; const float* cvec = args.in[1]; const float* w_mod = args.in[2]; const float* b_mod = args.in[3];
    const float* g_pre_mix = args.in[4]; const float* g_post_mix = args.in[5]; const float* w_in = args.in[6]; const float* g_gmlp_v = args.in[7];
    const float* w_spatial = args.in[8]; const float* b_spatial = args.in[9]; const float* g_out_gmlp = args.in[10]; const float* g_out_attn = args.in[11];
    const float* w_out = args.in[12]; const float* g_pre_ffn = args.in[13]; const float* g_post_ffn = args.in[14];
    const float* w_rg = args.in[15]; const float* b_rg = args.in[16]; const float* w_re = args.in[17]; const float* b_re = args.in[18];
    const float* w_gate = args.in[19]; const float* w_up = args.in[20]; const float* w_down = args.in[21];
    float* out = args.out;
    int* ROWTOK = (int*)(ws + WS_ROWTOK); float* MOD = (float*)(ws + WS_MOD); bf16* WSM = (bf16*)(ws + WS_WSM); float* YASS = (float*)(ws + WS_YASS);
    int* EID = (int*)(ws + WS_EID); int* LRANK = (int*)(ws + WS_LRANK); float* WT = (float*)(ws + WS_WT); int* TOKPOS = (int*)(ws + WS_TOKPOS); int* LIST = (int*)(ws + WS_LIST); unsigned* ECNT = ctl + CW_ECNT;
    float* ML = (float*)(ws + WS_ML); bf16* WRF = (bf16*)(ws + WS_WRF);
    bf16* WIN = (bf16*)(ws + WS_WIN); bf16* WOUT = (bf16*)(ws + WS_WOUT); unsigned char* WGU = ws + WS_WGU; unsigned char* WDN = ws + WS_WDN; unsigned char* HB8 = ws + WS_HB;
    bf16* HB = (bf16*)(ws + WS_HB); unsigned char* YC8 = ws + WS_HB + 64 * MiB; bf16* PROJ = (bf16*)(ws + WS_PROJ); bf16* QKV = (bf16*)(ws + WS_QKV); unsigned char* OPART = ws + WS_OPART; unsigned char* Y1 = ws + WS_Y1;
    float* VST = (float*)(ws + 20 * MiB);
    unsigned char* ACT = ws + WS_ACT; unsigned char* YBUF = ws + WS_YBUF; bf16* X1B = (bf16*)(ws + WS_OPART);

    for (int u = tid; u < 2048 / 4; u += NWAVES * 64) ((LAS unsigned*)(lds + MISC_OFF))[u] = 0u;
    __syncthreads();
    XcdBarrier bar; bar.bar = ctl + CW_BAR; bar.x = 0; bar.st = nullptr;
    if (MK_N_LAUNCHES == 1) bar = xcd_barrier_post(ctl + CW_BAR, (volatile LAS unsigned*)(lds + MISC_OFF));
    const int lo = args.ph_lo, hi = args.ph_hi;
#define IN(k) (lo <= (k) && (k) < hi)
    unsigned long long t_ext = 0, t_ph = kAnyAmp ? __builtin_amdgcn_s_memrealtime() : 0ull;
#define TSTAMP(k) do { if constexpr (kAnyAmp) { const unsigned long long now_ = __builtin_amdgcn_s_memrealtime(); t_ext += (now_ - t_ph) * (unsigned long long)kAmp[k]; t_ph = now_; } } while (0)
#define SEAM(k) do { if (MK_N_LAUNCHES == 1 && IN(k) && IN((k) + 1)) xcd_barrier(bar); TSTAMP(k); } while (0)

    constexpr int XI_IN = 16 * 160, XI_OUT = 16 * 64, XI_G = 16 * 32 * 32, XI_D = 8 * 64 * 32, XI_FRONT = XI_IN + XI_OUT, XI_ALL = XI_FRONT + 2 * XI_G + XI_D;
    auto xpose_items = [&](int it, const int it_end, const int stride) __attribute__((always_inline)) {
        LAS float* scr = (LAS float*)(lds + wave * 16896);
        const int cl = lane & 7, kq = lane >> 3, c4 = lane >> 4, nn = lane & 15;
        const float* src; unsigned char* dst; int N, ldk;
#define P0_DECODE(it_) do { int r = (it_); \
            if (r < XI_IN) { const int kb = r / 160, nb = r % 160; N = DIN; ldk = DM; src = w_in + (size_t)(kb * 128) * DIN + nb * 32; dst = (unsigned char*)WIN + (size_t)(nb * 32) * DM + kb * 128; } \
            else if ((r -= XI_IN) < XI_OUT) { const int kb = r / 64, nb = r % 64; N = DM; ldk = DM; src = w_out + (size_t)(kb * 128) * DM + nb * 32; dst = (unsigned char*)WOUT + (size_t)(nb * 32) * DM + kb * 128; } \
            else if ((r -= XI_OUT) < 2 * XI_G) { const int up = r >= XI_G; if (up) r -= XI_G; const int e = r / 512, q = r % 512, kb = q / 32, nb = q % 32, n0 = nb * 32; \
                N = DE; ldk = DM; src = (up ? w_up : w_gate) + (size_t)e * DM * DE + (size_t)(kb * 128) * DE + n0; dst = WGU + ((size_t)(e * 8 + (n0 >> 7)) * 256 + (n0 & 127) + (up ? 128 : 0)) * DM + kb * 128; } \
            else { r -= 2 * XI_G; const int e = r / 512, q = r % 512, kb = q / 64, nb = q % 64; N = DM; ldk = DE; src = w_down + (size_t)e * DE * DM + (size_t)(kb * 128) * DM + nb * 32; dst = WDN + ((size_t)e * DM + nb * 32) * DE + kb * 128; } } while (0)
#define P0_LOAD() do { _Pragma("unroll") for (int i = 0; i < 16; ++i) tv[i] = __builtin_nontemporal_load((const f32x4*)(src + (size_t)(8 * i + kq) * N + 4 * cl)); } while (0)
        f32x4 tv[16];
        if (it < it_end) { P0_DECODE(it); P0_LOAD(); }
        while (it < it_end) {
            unsigned char* const dcur = dst; const int lcur = ldk;
#pragma unroll
            for (int i = 0; i < 16; ++i) { LAS float* s = scr + (8 * i + kq) * 33 + 4 * cl; s[0] = tv[i][0]; s[1] = tv[i][1]; s[2] = tv[i][2]; s[3] = tv[i][3]; }
            it += stride;
            if (it < it_end) { P0_DECODE(it); P0_LOAD(); }
            asm volatile("s_waitcnt lgkmcnt(0)" ::: "memory");
#pragma unroll
            for (int i2 = 0; i2 < 2; ++i2)
#pragma unroll
                for (int hh = 0; hh < 2; ++hh) { const int n = nn + 16 * i2, kc = 16 * (c4 + 4 * hh); const LAS float* s = scr + kc * 33 + n; u32x4 o;
                    o.x = cvt4_fp8(64.f * s[0], 64.f * s[33], 64.f * s[2 * 33], 64.f * s[3 * 33]); o.y = cvt4_fp8(64.f * s[4 * 33], 64.f * s[5 * 33], 64.f * s[6 * 33], 64.f * s[7 * 33]);
                    o.z = cvt4_fp8(64.f * s[8 * 33], 64.f * s[9 * 33], 64.f * s[10 * 33], 64.f * s[11 * 33]); o.w = cvt4_fp8(64.f * s[12 * 33], 64.f * s[13 * 33], 64.f * s[14 * 33], 64.f * s[15 * 33]);
                    __builtin_nontemporal_store(o, (u32x4*)(dcur + (size_t)n * lcur + kc)); }
            asm volatile("s_waitcnt lgkmcnt(0)" ::: "memory");
        }
#undef P0_DECODE
#undef P0_LOAD
    };

    if (IN(0)) {
        {
            LAS float* sc = (LAS float*)lds; LAS float* red = (LAS float*)(lds + 32768);
            const int kg = tid >> 4, cl = tid & 15;
            for (int u = c; u < NMOD / 64; u += G) {
                const int n0 = u * 64;
                for (int i = tid; i < NB * DM; i += 512) sc[i] = silu_f(cvec[i]);
                __syncthreads();
                float acc[4][4];
#pragma unroll
                for (int b = 0; b < 4; ++b)
#pragma unroll
                    for (int j = 0; j < 4; ++j) acc[b][j] = 0.f;
#pragma unroll 4
                for (int k = kg; k < DM; k += 32) { const f32x4 w = *(const f32x4*)(w_mod + (size_t)k * NMOD + n0 + 4 * cl);
#pragma unroll
                    for (int b = 0; b < 4; ++b) { const float s = sc[b * DM + k];
#pragma unroll
                        for (int j = 0; j < 4; ++j) acc[b][j] += s * w[j]; } }
#pragma unroll
                for (int b = 0; b < 4; ++b)
#pragma unroll
                    for (int j = 0; j < 4; ++j) red[(kg * 4 + b) * 64 + 4 * cl + j] = acc[b][j];
                __syncthreads();
                if (tid < 256) { const int b = tid >> 6, n = tid & 63; float s = 0.f; for (int q = 0; q < 32; ++q) s += red[(q * 4 + b) * 64 + n]; MOD[b * NMOD + n0 + n] = s + b_mod[n0 + n]; }
                asm volatile("s_waitcnt vmcnt(0)" ::: "memory");
                __syncthreads();
                if (tid == 0 && u < 64) { __builtin_amdgcn_fence(__ATOMIC_RELEASE, "agent"); (void)xb_add(ctl + CW_MODC, 1u); }
            }
        }
        xpose_items(gw, XI_FRONT, NGW);
        for (int i = c * 512 + tid; i < 8 * 128 * 128; i += G * 512) { const int s = i & 127, t = (i >> 7) & 127; const float v = s <= t ? w_spatial[i] : 0.f; WSM[i] = (bf16)(cvtpk(v, 0.f) & 0xffffu); }
        for (int i = c * 512 + tid; i < 384 * 64; i += G * 512) {
            const int fl = i & 63, frag = i >> 6, part = frag & 1, nt = (frag >> 1) % 3, ks = (frag >> 1) / 3, n = 16 * nt + (fl & 15); float f[8];
#pragma unroll
            for (int j = 0; j < 8; ++j) { const int k = 32 * ks + 8 * (fl >> 4) + j; float w = 0.f;
                if (n < 4) w = w_rg[(size_t)k * 4 + n]; else if (n < 36) w = w_re[((size_t)((n - 4) >> 3) * DM + k) * 8 + ((n - 4) & 7)];
                const float hi = bflo(cvtpk(w, 0.f)); f[j] = part ? (w - hi) : hi; }
            *(u32x4*)(WRF + (size_t)i * 8) = pack8(f); }
    }
    TSTAMP(0);

    if (IN(1)) {
        if (MK_N_LAUNCHES == 1 && IN(0)) { if (tid == 0) { XB_SPIN(xb_ld(ctl + CW_MODC) < 64u, bar.bar); __builtin_amdgcn_fence(__ATOMIC_ACQUIRE, "agent"); } __syncthreads(); }
        const int RPW = NTOK / NGW, row0 = gw * RPW, b = row0 / SEQ;
        float av[32], sv[32];
#pragma unroll
        for (int j = 0; j < 4; ++j)
#pragma unroll
            for (int i = 0; i < 8; ++i) { const int ch = 512 * j + 8 * lane + i; av[8 * j + i] = g_pre_mix[ch] * (1.0f + MOD[b * NMOD + 1 * DM + ch]); sv[8 * j + i] = MOD[b * NMOD + 0 * DM + ch]; }
        for (int r = 0; r < RPW; ++r) {
            const float* xr = x + (size_t)(row0 + r) * DM; float xv[32]; float ss = 0.f;
#pragma unroll
            for (int j = 0; j < 4; ++j) { const f32x4 a = __builtin_nontemporal_load((const f32x4*)(xr + 512 * j + 8 * lane)), bq = __builtin_nontemporal_load((const f32x4*)(xr + 512 * j + 8 * lane + 4));
#pragma unroll
                for (int i = 0; i < 4; ++i) { xv[8 * j + i] = a[i]; xv[8 * j + 4 + i] = bq[i]; ss += a[i] * a[i] + bq[i] * bq[i]; } }
            const float rstd = __builtin_amdgcn_rsqf(wave_sum(ss) * (1.0f / DM) + EPS);
            unsigned char* hr = (unsigned char*)HB + (size_t)(row0 + r) * DM;
#pragma unroll
            for (int j = 0; j < 4; ++j) { float f[8];
#pragma unroll
                for (int i = 0; i < 8; ++i) f[i] = xv[8 * j + i] * rstd * av[8 * j + i] + sv[8 * j + i];
                u32x2 h8; h8.x = cvt4_fp8(f[0], f[1], f[2], f[3]); h8.y = cvt4_fp8(f[4], f[5], f[6], f[7]); *(u32x2*)(hr + 512 * j + 8 * lane) = h8; }
        }
    }
    SEAM(1);

    if (IN(2)) {
        pg8::Gemm g{HB, WIN, DM / 2, DM / 2, nullptr, -6, nullptr}; pg8::StaticOrder S; S.init(NTOK / 256, DIN / 256, G, c);
        pg8::EpiInProj E{PROJ, PP, QKV, VST};
        const int ksplit = MK_N_LAUNCHES == 1 ? (c % 10) : 0;
        S.i0 = 0; S.i1 = ksplit; pg8::gemm_phase<pg8::EpiInProj, pg8::StaticOrder, false, false, true>(lds, g, S, E);
        __syncthreads();
        xpose_items(XI_FRONT + gw, XI_FRONT + XI_G, NGW);
        asm volatile("s_waitcnt vmcnt(0)" ::: "memory");
        __syncthreads();
        S.i0 = ksplit; S.i1 = 0x7fffffff; pg8::gemm_phase<pg8::EpiInProj, pg8::StaticOrder, false, false, true>(lds, g, S, E);
    }
    SEAM(2);

    auto p3_body = [&]() __attribute__((always_inline)) {
        {
            LAS unsigned char* VT = lds; LAS f32x2* stats = (LAS f32x2*)(lds + 81920); LAS float* ssqL = (LAS float*)(lds + 83968);
            const int r32 = lane & 31, hh2 = lane >> 5, blk = (lane >> 4) & 1, q4 = (lane & 15) >> 2, p4 = lane & 3;
            const int tb = wave & 3, dh = wave >> 2;
            for (int u = c; u < NTOK / 128; u += G) {
                const int t0 = u * 128;
                if (tid < 128) {
                    const f32x4* pp = (const f32x4*)(VST + (size_t)(t0 + tid) * 32); float s1 = 0.f, s2 = 0.f;
#pragma unroll
                    for (int k = 0; k < 8; ++k) { const f32x4 v = pp[k]; s1 += v[0] + v[2]; s2 += v[1] + v[3]; }
                    const float mean = s1 * (1.0f / DG), var = s2 * (1.0f / DG) - mean * mean;
                    stats[tid] = (f32x2){mean, __builtin_amdgcn_rsqf(fmaxf(var, 0.f) + EPS)}; }
                __syncthreads();
                float ssq4[4] = {0.f, 0.f, 0.f, 0.f};
#define P3_VLOAD(dst_, hh_) do { _Pragma("unroll") for (int q = 0; q < 4; ++q) { const int idx = tid + 512 * q, s = idx >> 4, ch = idx & 15; \
                    dst_[q] = *(const u32x4*)(PROJ + (size_t)(t0 + s) * PP + DG + (hh_) * 128 + 8 * ch); } } while (0)
#define P3_VWRITE(src_, hh_, buf_) do { _Pragma("unroll") for (int q = 0; q < 4; ++q) { const int idx = tid + 512 * q, s = idx >> 4, ch = idx & 15; float f[8]; unpack8(src_[q], f); \
                    const f32x2 st = stats[s]; const f32x4 ga = *(const f32x4*)(g_gmlp_v + (hh_) * 128 + 8 * ch), gb = *(const f32x4*)(g_gmlp_v + (hh_) * 128 + 8 * ch + 4); \
                    _Pragma("unroll") for (int i = 0; i < 4; ++i) { f[i] = (f[i] - st.x) * st.y * ga[i]; f[4 + i] = (f[4 + i] - st.x) * st.y * gb[i]; } \
                    *(LAS u32x4*)(VT + (buf_) * 40960 + s * 320 + ch * 16) = pack8(f); } } while (0)
                u32x4 vraw[4];
                P3_VLOAD(vraw, 0); P3_VWRITE(vraw, 0, 0);
                __syncthreads();
                const int nks = 2 * (tb + 1);
                bf16x8 bwf[8];
                { const bf16* wrow = WSM + ((size_t)(32 * tb + r32)) * 128 + 8 * hh2;
#pragma unroll
                  for (int ks = 0; ks < 8; ++ks) bwf[ks] = *(const bf16x8*)(wrow + 16 * (ks < nks ? ks : 0)); }
                for (int hh = 0; hh < 8; ++hh) {
                    const int buf = hh & 1, hn = hh + 1 < 8 ? hh + 1 : hh;
                    P3_VLOAD(vraw, hn);
                    u32x4 uraw[4]; float bsp4[4];
                    const f32x4 gya = *(const f32x4*)(g_out_gmlp + hh * 128 + 64 * dh + 8 * (lane & 7)), gyb = *(const f32x4*)(g_out_gmlp + hh * 128 + 64 * dh + 8 * (lane & 7) + 4);
#pragma unroll
                    for (int i = 0; i < 4; ++i) { const int row = (lane >> 3) + 8 * i; uraw[i] = *(const u32x4*)(PROJ + (size_t)(t0 + 32 * tb + row) * PP + hh * 128 + 64 * dh + 8 * (lane & 7)); bsp4[i] = b_spatial[hh * 128 + 32 * tb + row]; }
                    f32x16 acc0 = {}, acc1 = {};
                    const LAS unsigned char* vb = VT + buf * 40960 + (8 * hh2 + q4) * 320 + (64 * dh + 16 * blk + 4 * p4) * 2;
#pragma unroll
                    for (int ks = 0; ks < 8; ++ks) if (ks < nks) {
                        const LAS unsigned char* vk = vb + ks * 16 * 320;
                        const s16x4 l0 = vtr(vk), h0 = vtr(vk + 4 * 320), l1 = vtr(vk + 64), h1 = vtr(vk + 4 * 320 + 64);
                        const bf16x8 a0 = {l0[0], l0[1], l0[2], l0[3], h0[0], h0[1], h0[2], h0[3]}, a1 = {l1[0], l1[1], l1[2], l1[3], h1[0], h1[1], h1[2], h1[3]};
                        acc0 = MFMA32(a0, bwf[ks], acc0); acc1 = MFMA32(a1, bwf[ks], acc1);
                    }
                    { const bf16* wrow = WSM + ((size_t)(hn * 128 + 32 * tb + r32)) * 128 + 8 * hh2;
#pragma unroll
                      for (int ks = 0; ks < 8; ++ks) bwf[ks] = *(const bf16x8*)(wrow + 16 * (ks < nks ? ks : 0)); }
                    {
                        LAS unsigned char* stg = lds + 86016 + wave * 8704;
#pragma unroll
                        for (int db = 0; db < 2; ++db)
#pragma unroll
                            for (int gq = 0; gq < 4; ++gq) { const f32x16& A = db ? acc1 : acc0;
                                *(LAS f32x4*)(stg + r32 * 272 + (32 * db + 8 * gq + 4 * hh2) * 4) = (f32x4){A[4 * gq + 0], A[4 * gq + 1], A[4 * gq + 2], A[4 * gq + 3]}; }
                        asm volatile("s_waitcnt lgkmcnt(0)" ::: "memory");
#pragma unroll
                        for (int i = 0; i < 4; ++i) { const int row = (lane >> 3) + 8 * i, ch = lane & 7;
                            unsigned char* pu = YC8 + (size_t)(t0 + 32 * tb + row) * DM + hh * 128 + 64 * dh + 8 * ch;
                            const f32x4 s0 = *(const LAS f32x4*)(stg + row * 272 + ch * 32), s1 = *(const LAS f32x4*)(stg + row * 272 + ch * 32 + 16);
                            float f[8]; unpack8(uraw[i], f); const float bsp = bsp4[i];
#pragma unroll
                            for (int j = 0; j < 4; ++j) { f[j] *= (s0[j] + bsp); f[4 + j] *= (s1[j] + bsp); }
#pragma unroll
                            for (int j = 0; j < 8; ++j) ssq4[i] += f[j] * f[j];
                            u32x2 o; o.x = cvt4_fp8(f[0] * gya[0], f[1] * gya[1], f[2] * gya[2], f[3] * gya[3]); o.y = cvt4_fp8(f[4] * gyb[0], f[5] * gyb[1], f[6] * gyb[2], f[7] * gyb[3]);
                            *(u32x2*)pu = o; }
                        asm volatile("s_waitcnt lgkmcnt(0)" ::: "memory");
                    }
                    if (hh + 1 < 8) P3_VWRITE(vraw, hh + 1, buf ^ 1);
                    __syncthreads();
                }
#undef P3_VLOAD
#undef P3_VWRITE
#pragma unroll
                for (int i = 0; i < 4; ++i) { float q = ssq4[i]; q += __shfl_xor(q, 1); q += __shfl_xor(q, 2); q += __shfl_xor(q, 4); if ((lane & 7) == 0) ssqL[wave * 32 + (lane >> 3) + 8 * i] = q; }
                __syncthreads();
                if (tid < 128) YASS[t0 + tid] = ssqL[(tid >> 5) * 32 + (tid & 31)] + ssqL[((tid >> 5) + 4) * 32 + (tid & 31)];
                __syncthreads();
            }
        }
    };
    TSTAMP(3);
    if (IN(4)) {
        LAS unsigned char* KT = lds; LAS unsigned char* VT = lds + 65536; LAS unsigned char* QT = lds + 131072;
        const unsigned keep0 = ((volatile LAS unsigned*)(lds + MISC_OFF))[0], keep1 = ((volatile LAS unsigned*)(lds + MISC_OFF))[1];
        __syncthreads();
        const int fr = lane & 15, g = lane >> 4, q4 = (lane & 15) >> 2, p4 = lane & 3;
        const int UPW = 6144 / G;
        unsigned vaddr[8];
#pragma unroll
        for (int db = 0; db < 8; ++db) vaddr[db] = (unsigned)(size_t)(VT + (16 * wave + 4 * g + q4) * 256 + 8 * p4 + ((db ^ (4 * (g & 1) + q4)) << 5));
        const int lrow = 16 * wave + (lane >> 4);
        const int sw0 = ((((lane & 15) >> 1) ^ (lane >> 4)) << 4) + ((lane & 1) << 3), sw1 = ((((lane & 15) >> 1) ^ (4 + (lane >> 4))) << 4) + ((lane & 1) << 3);
#define P4_DECODE(uid_, pat_, tbase_, hbase_, dl_, qb_, head_) do { const int bh_ = (uid_) / 192, r_ = (uid_) % 192, xq_ = r_ & 63; pat_ = r_ >> 6; \
            dl_ = pat_ == 0 ? 1 : (pat_ == 1 ? 4 : 16); const int nblk_ = 64 / dl_, res_ = xq_ / nblk_; qb_ = xq_ % nblk_; head_ = bh_ & 7; tbase_ = (size_t)(bh_ >> 3) * SEQ + res_; hbase_ = (size_t)bh_ * SEQ + res_; } while (0)
#define P4_ISSUE(T_, which_, hbase_, dl_, qb_, blk_) do { const bf16* b_ = QKV + (size_t)(which_) * NTOK * 1024 + (hbase_) * 128; const int m0_ = 128 * (qb_) - 128 + 128 * (blk_) + lrow; const int xr_ = ((qb_) & 1) ? 0 : 128; \
            _Pragma("unroll") for (int i_ = 0; i_ < 4; ++i_) { int mk_ = m0_ + 4 * i_; mk_ = mk_ < 0 ? 0 : mk_; \
            __builtin_amdgcn_global_load_lds((const unsigned*)(b_ + (size_t)(mk_ * (dl_)) * 128 + ((i_ & 1) ? sw1 : sw0)), (LAS unsigned*)((T_) + (((128 * (blk_) + 16 * wave + 4 * i_) ^ xr_) << 8)), 16, 0, 0); } } while (0)
#define P4_QISSUE(hbase_, dl_, qb_) do { const bf16* q_ = QKV + ((hbase_) + (size_t)(128 * (qb_) + 16 * wave + (lane >> 4)) * (dl_)) * 128; \
            _Pragma("unroll") for (int i_ = 0; i_ < 4; ++i_) \
            __builtin_amdgcn_global_load_lds((const unsigned*)(q_ + (size_t)(4 * i_ * (dl_)) * 128 + ((i_ & 1) ? sw1 : sw0)), (LAS unsigned*)(QT + (16 * wave + 4 * i_) * 256), 16, 0, 0); } while (0)
        int pat, dl, qb, head; size_t tbase, hbase;
        const int vc = (((c & 7) + 8 * (c >> 6)) << 3) + ((c >> 3) & 7);
#define P4_UID(ui_) (((vc >> 3) * 192) + 64 * ((ui_) >> 3) + 8 * (vc & 7) + ((ui_) & 7))
        { const int uid0 = P4_UID(0); P4_DECODE(uid0, pat, tbase, hbase, dl, qb, head); P4_ISSUE(KT, 1, hbase, dl, qb, 0); P4_ISSUE(KT, 1, hbase, dl, qb, 1); P4_QISSUE(hbase, dl, qb); P4_ISSUE(VT, 2, hbase, dl, qb, 0); P4_ISSUE(VT, 2, hbase, dl, qb, 1); }
        bool both = true;
        for (int ui = 0; ui < UPW; ++ui) {
            const size_t tq = tbase + (size_t)(128 * qb + 16 * wave + fr) * dl;
            const unsigned xb = (qb & 1) ? 0u : 0x8000u;
            if (ui == 0) asm volatile("s_waitcnt vmcnt(8)" ::: "memory"); else if (both) asm volatile("s_waitcnt vmcnt(11)" ::: "memory"); else asm volatile("s_waitcnt vmcnt(7)" ::: "memory");
            __builtin_amdgcn_s_barrier(); asm volatile("" ::: "memory");
            f32x4 S[9];
            {
                const unsigned kb0 = (unsigned)(size_t)(KT + (16 * wave + fr) * 256 + ((g & 1) << 4));
                const LAS unsigned char* qb0 = QT + (16 * wave + fr) * 256 + ((g & 1) << 4);
                const int sw = fr & 7;
                bf16x8 qf[4];
#pragma unroll
                for (int ks = 0; ks < 4; ++ks) qf[ks] = *(const LAS bf16x8*)(qb0 + (((2 * ks + (g >> 1)) ^ sw) << 5));
                bf16x8 kf[9][4];
#pragma unroll
                for (int kb = 0; kb < 9; ++kb)
#pragma unroll
                    for (int ks = 0; ks < 4; ++ks) kf[kb][ks] = *(const LAS bf16x8*)(size_t)(((kb0 + kb * 4096) ^ xb) + (((2 * ks + (g >> 1)) ^ sw) << 5));
#pragma unroll
                for (int kb = 0; kb < 9; ++kb) { f32x4 a = {0.f, 0.f, 0.f, 0.f};
#pragma unroll
                    for (int ks = 0; ks < 4; ++ks) a = __builtin_amdgcn_mfma_f32_16x16x32_bf16(kf[kb][ks], qf[ks], a, 0, 0, 0);
                    S[kb] = a; }
            }
            const int mk0 = 128 * qb - 128 + 16 * wave;
#pragma unroll
            for (int r = 0; r < 4; ++r) { if (4 * g + r < fr) S[0][r] = -INFINITY; if (4 * g + r > fr) S[8][r] = -INFINITY; }
            if (mk0 < 0) {
#pragma unroll
                for (int kb = 0; kb < 9; ++kb)
#pragma unroll
                    for (int r = 0; r < 4; ++r) if (mk0 + 16 * kb + 4 * g + r < 0) S[kb][r] = -INFINITY; }
            float mx = -INFINITY;
#pragma unroll
            for (int kb = 0; kb < 9; ++kb)
#pragma unroll
                for (int r = 0; r < 4; ++r) mx = fmaxf(mx, S[kb][r]);
            mx = fmaxf(mx, __shfl_xor(mx, 16)); mx = fmaxf(mx, __shfl_xor(mx, 32));
            float lsum = 0.f;
#pragma unroll
            for (int kb = 0; kb < 9; ++kb)
#pragma unroll
                for (int r = 0; r < 4; ++r) { const float pv = __builtin_amdgcn_exp2f(S[kb][r] - mx); S[kb][r] = pv; lsum += pv; }
            lsum += __shfl_xor(lsum, 16); lsum += __shfl_xor(lsum, 32);
            bf16x8 pf[5];
#pragma unroll
            for (int s2 = 0; s2 < 5; ++s2) { u32x4 w; w.x = cvtpk(S[2 * s2][0], S[2 * s2][1]); w.y = cvtpk(S[2 * s2][2], S[2 * s2][3]);
                if (s2 < 4) { w.z = cvtpk(S[2 * s2 + 1][0], S[2 * s2 + 1][1]); w.w = cvtpk(S[2 * s2 + 1][2], S[2 * s2 + 1][3]); } else { w.z = 0u; w.w = 0u; }
                pf[s2] = __builtin_bit_cast(bf16x8, w); }
            asm volatile("s_waitcnt vmcnt(0) lgkmcnt(0)" ::: "memory"); __builtin_amdgcn_s_barrier(); asm volatile("" ::: "memory");
            int pat_n, dl_n, qb_n, head_n; size_t tbase_n, hbase_n;
            const bool more = ui + 1 < UPW;
            const int uidc = P4_UID(ui), uidn = more ? P4_UID(ui + 1) : uidc;
            { P4_DECODE(uidn, pat_n, tbase_n, hbase_n, dl_n, qb_n, head_n); }
            const bool both_n = more && !(uidn == uidc + 1 && qb_n != 0);
            if (both_n) P4_ISSUE(KT, 1, hbase_n, dl_n, qb_n, 0);
            P4_ISSUE(KT, 1, hbase_n, dl_n, qb_n, 1); P4_QISSUE(hbase_n, dl_n, qb_n);
            f32x4 O[8];
#pragma unroll
            for (int db = 0; db < 8; ++db) O[db] = (f32x4){0.f, 0.f, 0.f, 0.f};
            {
                unsigned va[8];
#pragma unroll
                for (int db = 0; db < 8; ++db) va[db] = vaddr[db] ^ xb;
                s16x4 LA[8], HA[8], LB[8], HB_[8];
#define P4_TR(dst_, db_, off_) do { const unsigned a_ = (vaddr[db_] + (off_)) ^ xb; asm volatile("ds_read_b64_tr_b16 %0, %1" : "=v"(dst_) : "v"(a_) : "memory"); } while (0)
#define P4_RD(L_, H_, s2_) do { _Pragma("unroll") for (int db = 0; db < 8; ++db) { P4_TR(L_[db], db, (s2_) * 8192); P4_TR(H_[db], db, (s2_) < 4 ? (s2_) * 8192 + 4096 : (s2_) * 8192); } } while (0)
#define P4_WT(L_, H_) do { asm volatile("s_waitcnt lgkmcnt(0)" : "+v"(L_[0]), "+v"(L_[1]), "+v"(L_[2]), "+v"(L_[3]), "+v"(L_[4]), "+v"(L_[5]), "+v"(L_[6]), "+v"(L_[7]), \
                    "+v"(H_[0]), "+v"(H_[1]), "+v"(H_[2]), "+v"(H_[3]), "+v"(H_[4]), "+v"(H_[5]), "+v"(H_[6]), "+v"(H_[7]) :: "memory"); __builtin_amdgcn_sched_barrier(0); } while (0)
#define P4_MM(L_, H_, s2_) do { _Pragma("unroll") for (int db = 0; db < 8; ++db) { const bf16x8 av = {L_[db][0], L_[db][1], L_[db][2], L_[db][3], H_[db][0], H_[db][1], H_[db][2], H_[db][3]}; \
                    O[db] = __builtin_amdgcn_mfma_f32_16x16x32_bf16(av, pf[s2_], O[db], 0, 0, 0); } } while (0)
                (void)va;
                P4_RD(LA, HA, 0); P4_WT(LA, HA);
                P4_RD(LB, HB_, 1); P4_MM(LA, HA, 0); P4_WT(LB, HB_);
                P4_RD(LA, HA, 2); P4_MM(LB, HB_, 1); P4_WT(LA, HA);
                P4_RD(LB, HB_, 3); P4_MM(LA, HA, 2); P4_WT(LB, HB_);
                P4_RD(LA, HA, 4); P4_MM(LB, HB_, 3); P4_WT(LA, HA);
                P4_MM(LA, HA, 4);
#undef P4_TR
#undef P4_RD
#undef P4_WT
#undef P4_MM
            }
            asm volatile("s_waitcnt lgkmcnt(0)" ::: "memory"); __builtin_amdgcn_s_barrier(); asm volatile("" ::: "memory");
            {
                LAS unsigned char* stg = VT + (((16 * wave) << 8) ^ xb);
#pragma unroll
                for (int db = 0; db < 8; ++db) *(LAS unsigned*)(stg + fr * 128 + ((db ^ (fr & 7)) << 4) + 4 * g) = cvt4_fp8(O[db][0], O[db][1], O[db][2], O[db][3]);
                asm volatile("s_waitcnt lgkmcnt(0)" ::: "memory");
                u32x4 ov[2];
#pragma unroll
                for (int i = 0; i < 2; ++i) { const int r = 8 * i + (lane >> 3); ov[i] = *(const LAS u32x4*)(stg + r * 128 + (((lane & 7) ^ (r & 7)) << 4)); }
                asm volatile("s_waitcnt lgkmcnt(0)" ::: "memory");
                const size_t tq8 = tbase + (size_t)(128 * qb + 16 * wave + (lane >> 3)) * dl;
                unsigned char* ob = OPART + ((size_t)pat * NTOK + tq8) * DG + head * 128 + 16 * (lane & 7);
#pragma unroll
                for (int i = 0; i < 2; ++i) __builtin_nontemporal_store(ov[i], (u32x4*)(ob + (size_t)(8 * i * dl) * DG));
            }
            if (both_n) P4_ISSUE(VT, 2, hbase_n, dl_n, qb_n, 0);
            P4_ISSUE(VT, 2, hbase_n, dl_n, qb_n, 1);
            *(f32x2*)(ML + (((size_t)pat * NTOK + tq) * 8 + head) * 2) = (f32x2){mx, lsum};
            pat = pat_n; dl = dl_n; qb = qb_n; head = head_n; tbase = tbase_n; hbase = hbase_n; both = both_n;
        }
        asm volatile("s_waitcnt vmcnt(0)" ::: "memory");
        __syncthreads();
        if (tid == 0) { ((volatile LAS unsigned*)(lds + MISC_OFF))[0] = keep0; ((volatile LAS unsigned*)(lds + MISC_OFF))[1] = keep1; }
        __syncthreads();
#undef P4_DECODE
#undef P4_ISSUE
#undef P4_QISSUE
#undef P4_UID
    }
    SEAM(4);

    const bool p3_last = MK_N_LAUNCHES == 1 ? (((c >> 3) & 1) != 0) : false;
    auto p5_body = [&]() __attribute__((always_inline)) {
    if (IN(5)) {
        const int RPW = NTOK / NGW, row0 = gw * RPW, head = lane >> 3;
        float gb[16];
#pragma unroll
        for (int i = 0; i < 16; ++i) gb[i] = g_out_attn[16 * lane + i];
        for (int r0 = 0; r0 < RPW; r0 += 2) {
            f32x2 ml[2][3]; u32x4 o8[2][3];
#pragma unroll
            for (int q = 0; q < 2; ++q)
#pragma unroll
                for (int p = 0; p < 3; ++p) { const size_t row = (size_t)(row0 + r0 + q); ml[q][p] = *(const f32x2*)(ML + (((size_t)p * NTOK + row) * 8 + head) * 2);
                    o8[q][p] = __builtin_nontemporal_load((const u32x4*)(OPART + ((size_t)p * NTOK + row) * DG + 16 * lane)); }
#pragma unroll
            for (int q = 0; q < 2; ++q) {
                const size_t row = (size_t)(row0 + r0 + q);
                const float M = fmaxf(fmaxf(ml[q][0].x, ml[q][1].x), ml[q][2].x);
                float o[16]; float den = 0.f;
#pragma unroll
                for (int i = 0; i < 16; ++i) o[i] = 0.f;
#pragma unroll
                for (int p = 0; p < 3; ++p) { const float w = __builtin_amdgcn_exp2f(ml[q][p].x - M); den += w * ml[q][p].y;
                    float f[8], f2[8]; unpack8_fp8((u32x2){o8[q][p].x, o8[q][p].y}, f); unpack8_fp8((u32x2){o8[q][p].z, o8[q][p].w}, f2);
#pragma unroll
                    for (int i = 0; i < 8; ++i) { o[i] += w * f[i]; o[8 + i] += w * f2[i]; } }
                const float inv = 1.0f / den; float ss = 0.f;
#pragma unroll
                for (int i = 0; i < 16; ++i) { o[i] *= inv; ss += o[i] * o[i]; }
                const float rb = __builtin_amdgcn_rsqf(wave_sum(ss) * (1.0f / DG) + EPS);
                unsigned char* yc = YC8 + row * DM + 16 * lane;
                u32x4 w8; w8.x = cvt4_fp8(o[0] * rb * gb[0], o[1] * rb * gb[1], o[2] * rb * gb[2], o[3] * rb * gb[3]); w8.y = cvt4_fp8(o[4] * rb * gb[4], o[5] * rb * gb[5], o[6] * rb * gb[6], o[7] * rb * gb[7]);
                w8.z = cvt4_fp8(o[8] * rb * gb[8], o[9] * rb * gb[9], o[10] * rb * gb[10], o[11] * rb * gb[11]); w8.w = cvt4_fp8(o[12] * rb * gb[12], o[13] * rb * gb[13], o[14] * rb * gb[14], o[15] * rb * gb[15]);
                *(u32x4*)(yc + DG) = w8;
            }
        }
    }
    };
    if (p3_last) p5_body();
    if (IN(3)) p3_body();
    if (!p3_last) p5_body();
    SEAM(5);

    if (IN(6)) {
        pg8::Gemm g{(const bf16*)YC8, WOUT, DM / 2, DM / 2, nullptr, -6, YASS}; pg8::StaticOrder S; S.init(NTOK / 256, DM / 256, G, c);
        pg8::EpiPlain8 E{Y1, DM};
        const int ksplit = MK_N_LAUNCHES == 1 ? (c % 4) : 0;
        S.i0 = 0; S.i1 = ksplit; pg8::gemm_phase<pg8::EpiPlain8, pg8::StaticOrder, false, false, true, 8>(lds, g, S, E);
        __syncthreads();
        xpose_items(XI_FRONT + XI_G + gw, XI_FRONT + 2 * XI_G, NGW);
        asm volatile("s_waitcnt vmcnt(0)" ::: "memory");
        __syncthreads();
        S.i0 = ksplit; S.i1 = 0x7fffffff; pg8::gemm_phase<pg8::EpiPlain8, pg8::StaticOrder, false, false, true, 8>(lds, g, S, E);
    }
    SEAM(6);

    if (IN(7)) {
        const int TPW = NTOK / G, tok0 = c * TPW, b = tok0 / SEQ;
        LAS unsigned char* HI = lds; LAS unsigned char* LO = lds + 65536;
        LAS float* A1 = (LAS float*)(lds + 131072); LAS float* A2 = A1 + DM; LAS float* S2 = A2 + DM;
        LAS float* part = (LAS float*)lds;
        LAS float* logit = (LAS float*)(lds + XTRA_OFF);
        LAS int* hist = (LAS int*)(lds + MISC_OFF + 64); LAS int* eidL = (LAS int*)(lds + XTRA_OFF + 2560); LAS int* lrL = eidL + 256;
        for (int i = tid; i < DM; i += 512) { A1[i] = MOD[b * NMOD + 2 * DM + i] * g_post_mix[i]; A2[i] = g_pre_ffn[i] * (1.0f + MOD[b * NMOD + 4 * DM + i]); S2[i] = MOD[b * NMOD + 3 * DM + i]; }
        LAS float* rbias = (LAS float*)(lds + XTRA_OFF + 2304);
        if (tid < 36) rbias[tid] = tid < 4 ? b_rg[tid] : b_re[tid - 4];
        if (tid < 32) hist[tid] = 0;
        __syncthreads();
        const int fr = lane & 15, fq = lane >> 4;
        u32x2 yq[2][4]; f32x4 xq[2][8];
#define P7_LOAD(ti_) do { _Pragma("unroll") for (int rr2 = 0; rr2 < 2; ++rr2) { const int tok_ = tok0 + 16 * (ti_) + 2 * wave + rr2; \
            const float* xr_ = x + (size_t)tok_ * DM + 8 * lane; const unsigned char* yr_ = Y1 + (size_t)tok_ * DM + 8 * lane; \
            _Pragma("unroll") for (int j = 0; j < 4; ++j) { yq[rr2][j] = *(const u32x2*)(yr_ + 512 * j); xq[rr2][2 * j] = __builtin_nontemporal_load((const f32x4*)(xr_ + 512 * j)); xq[rr2][2 * j + 1] = __builtin_nontemporal_load((const f32x4*)(xr_ + 512 * j + 4)); } } } while (0)
        P7_LOAD(0);
        for (int ti = 0; ti < TPW / 16; ++ti) {
#pragma unroll
            for (int rr2 = 0; rr2 < 2; ++rr2) {
                const int rr = 2 * wave + rr2, tok = tok0 + 16 * ti + rr;
                unsigned char* hr = HB8 + (size_t)tok * DM;
                float xv[32], yv[32]; float ss = 0.f;
#pragma unroll
                for (int j = 0; j < 4; ++j) { float f[8]; unpack8_fp8(yq[rr2][j], f);
#pragma unroll
                    for (int i = 0; i < 8; ++i) { yv[8 * j + i] = f[i]; ss += f[i] * f[i]; } }
#pragma unroll
                for (int j = 0; j < 4; ++j) {
#pragma unroll
                    for (int i = 0; i < 4; ++i) { xv[8 * j + i] = xq[rr2][2 * j][i]; xv[8 * j + 4 + i] = xq[rr2][2 * j + 1][i]; } }
                const float r1 = __builtin_amdgcn_rsqf(wave_sum(ss) * (1.0f / DM) + EPS);
                float ss2 = 0.f;
#pragma unroll
                for (int j = 0; j < 4; ++j) { const f32x4 a0 = *(const LAS f32x4*)(A1 + 512 * j + 8 * lane), a1 = *(const LAS f32x4*)(A1 + 512 * j + 8 * lane + 4);
#pragma unroll
                    for (int i = 0; i < 4; ++i) { xv[8 * j + i] += a0[i] * yv[8 * j + i] * r1; xv[8 * j + 4 + i] += a1[i] * yv[8 * j + 4 + i] * r1; }
#pragma unroll
                    for (int i = 0; i < 8; ++i) ss2 += xv[8 * j + i] * xv[8 * j + i];
                    { float f[8];
#pragma unroll
                      for (int i = 0; i < 8; ++i) f[i] = xv[8 * j + i];
                      __builtin_nontemporal_store(pack8(f), (u32x4*)(X1B + (size_t)tok * DM + 512 * j + 8 * lane)); } }
                const float r2 = __builtin_amdgcn_rsqf(wave_sum(ss2) * (1.0f / DM) + EPS);
#pragma unroll
                for (int j = 0; j < 4; ++j) { const f32x4 a0 = *(const LAS f32x4*)(A2 + 512 * j + 8 * lane), a1 = *(const LAS f32x4*)(A2 + 512 * j + 8 * lane + 4);
                    const f32x4 s0 = *(const LAS f32x4*)(S2 + 512 * j + 8 * lane), s1 = *(const LAS f32x4*)(S2 + 512 * j + 8 * lane + 4);
                    float f[8], fl[8];
#pragma unroll
                    for (int i = 0; i < 4; ++i) { f[i] = xv[8 * j + i] * r2 * a0[i] + s0[i]; f[4 + i] = xv[8 * j + 4 + i] * r2 * a1[i] + s1[i]; }
                    const u32x4 hw = pack8(f); float fh[8]; unpack8(hw, fh);
#pragma unroll
                    for (int i = 0; i < 8; ++i) fl[i] = f[i] - fh[i];
                    { u32x2 h8; h8.x = cvt4_fp8(f[0], f[1], f[2], f[3]); h8.y = cvt4_fp8(f[4], f[5], f[6], f[7]); *(u32x2*)(hr + 512 * j + 8 * lane) = h8; }
                    const int off = rr * 4096 + (((64 * j + lane) ^ rr) << 4);
                    *(LAS u32x4*)(HI + off) = hw; *(LAS u32x4*)(LO + off) = pack8(fl); }
            }
            __syncthreads();
            f32x4 acc[3] = {{0.f, 0.f, 0.f, 0.f}, {0.f, 0.f, 0.f, 0.f}, {0.f, 0.f, 0.f, 0.f}};
#pragma unroll 4
            for (int s8 = 0; s8 < 8; ++s8) { const int ks = 8 * wave + s8; const int off = fr * 4096 + (((4 * ks + fq) ^ fr) << 4);
                const bf16x8 ah = *(const LAS bf16x8*)(HI + off), al = *(const LAS bf16x8*)(LO + off);
                const bf16* wf = WRF + ((size_t)(ks * 6) * 64 + lane) * 8;
#pragma unroll
                for (int nt = 0; nt < 3; ++nt) { const bf16x8 bh = *(const bf16x8*)(wf + (size_t)(2 * nt) * 512), bl = *(const bf16x8*)(wf + (size_t)(2 * nt + 1) * 512);
                    acc[nt] = __builtin_amdgcn_mfma_f32_16x16x32_bf16(ah, bh, acc[nt], 0, 0, 0);
                    acc[nt] = __builtin_amdgcn_mfma_f32_16x16x32_bf16(al, bh, acc[nt], 0, 0, 0);
                    acc[nt] = __builtin_amdgcn_mfma_f32_16x16x32_bf16(ah, bl, acc[nt], 0, 0, 0); } }
            if (ti + 1 < TPW / 16) P7_LOAD(ti + 1);
            __syncthreads();
#pragma unroll
            for (int nt = 0; nt < 3; ++nt)
#pragma unroll
                for (int r = 0; r < 4; ++r) part[(wave * 16 + 4 * fq + r) * 48 + 16 * nt + fr] = acc[nt][r];
            __syncthreads();
            { const int tk = tid >> 5, j = tid & 31;
              float sa = 0.f, sb = 0.f;
#pragma unroll
              for (int w = 0; w < 8; ++w) { sa += part[(w * 16 + tk) * 48 + j]; if (j < 4) sb += part[(w * 16 + tk) * 48 + 32 + j]; }
              logit[tk * 36 + j] = sa + rbias[j]; if (j < 4) logit[tk * 36 + 32 + j] = sb + rbias[32 + j]; }
            __syncthreads();
            if (tid < 16) {
                const int tok = tok0 + 16 * ti + tid; const LAS float* L = logit + tid * 36;
                float lg[4]; int gi = 0;
#pragma unroll
                for (int q = 0; q < 4; ++q) lg[q] = L[q];
                float gm = lg[0];
#pragma unroll
                for (int q = 1; q < 4; ++q) if (lg[q] > gm) { gm = lg[q]; gi = q; }
                float gden = 0.f;
#pragma unroll
                for (int q = 0; q < 4; ++q) gden += __expf(lg[q] - gm);
                const float gp = 1.0f / gden;
                float le[8];
#pragma unroll
                for (int q = 0; q < 8; ++q) le[q] = L[4 + 8 * gi + q];
                int i0 = 0; float m0 = le[0];
#pragma unroll
                for (int q = 1; q < 8; ++q) if (le[q] > m0) { m0 = le[q]; i0 = q; }
                int i1 = -1; float m1 = -INFINITY;
#pragma unroll
                for (int q = 0; q < 8; ++q) if (q != i0 && le[q] > m1) { m1 = le[q]; i1 = q; }
                const float e1 = __expf(m1 - m0), w0 = gp / (1.0f + e1), w1 = gp * e1 / (1.0f + e1);
                const int ea = gi * 8 + i0, eb = gi * 8 + i1;
                const int ra = __hip_atomic_fetch_add(hist + ea, 1, __ATOMIC_RELAXED, __HIP_MEMORY_SCOPE_WORKGROUP), rb = __hip_atomic_fetch_add(hist + eb, 1, __ATOMIC_RELAXED, __HIP_MEMORY_SCOPE_WORKGROUP);
                eidL[2 * (16 * ti + tid)] = ea; eidL[2 * (16 * ti + tid) + 1] = eb; lrL[2 * (16 * ti + tid)] = ra; lrL[2 * (16 * ti + tid) + 1] = rb; WT[2 * tok] = w0; WT[2 * tok + 1] = w1;
            }
        }
#undef P7_LOAD
        __syncthreads();
        LAS int* wbase = (LAS int*)(lds + MISC_OFF + 1536);
        if (tid < 32) wbase[tid] = (int)__hip_atomic_fetch_add(ECNT + tid, (unsigned)hist[tid], __ATOMIC_RELAXED, __HIP_MEMORY_SCOPE_AGENT);
        __syncthreads();
        for (int i = tid; i < 2 * TPW; i += 512) { const int e = eidL[i], pos = wbase[e] + lrL[i]; LIST[(size_t)e * LCAP + pos] = tok0 + (i >> 1); EID[2 * tok0 + i] = e; TOKPOS[2 * tok0 + i] = pos; }
    }
    SEAM(7);

    TSTAMP(8);

    if (IN(9)) {
        build_tiles2(ECNT, lds);
        const LAS int* ttab = (const LAS int*)(lds + MISC_OFF + 256);
        pg8::Gemm g{(const bf16*)HB8, (const bf16*)WGU, DM / 2, DM / 2, LIST, -6, nullptr}; pg8::MoeOrder S; S.init(ttab[0], 8, G, c); S.tile_e = ttab + 1; S.tile_l = (const LAS int*)(lds + XTRA_OFF);
        pg8::EpiSwiglu8 E{ACT, DE};
        const int ksplit = MK_N_LAUNCHES == 1 ? (c % 8) : 0;
        S.i0 = 0; S.i1 = ksplit; pg8::gemm_phase<pg8::EpiSwiglu8, pg8::MoeOrder, false, true, true>(lds, g, S, E);
        __syncthreads();
        {
            const int Hh = S.nwg % G, Ll = G - Hh, D0 = XI_FRONT + 2 * XI_G;
            if (Hh == 0) xpose_items(D0 + gw, XI_ALL, NGW);
            else { int a = (2048 - 5 * Ll + 128) / 256; a = a < 0 ? 0 : a; const int nheavy = Hh * NWAVES * a;
                if (c < Hh) xpose_items(D0 + gw, D0 + nheavy, Hh * NWAVES);
                else xpose_items(D0 + nheavy + (c - Hh) * NWAVES + wave, XI_ALL, Ll * NWAVES); }
        }
        asm volatile("s_waitcnt vmcnt(0)" ::: "memory");
        __syncthreads();
        S.i0 = ksplit; S.i1 = 0x7fffffff; pg8::gemm_phase<pg8::EpiSwiglu8, pg8::MoeOrder, false, true, true>(lds, g, S, E);
    }
    SEAM(9);

    if (IN(10)) {
        if (MK_N_LAUNCHES != 1) build_tiles2(ECNT, lds);
        const LAS int* ttab = (const LAS int*)(lds + MISC_OFF + 256);
        pg8::Gemm g{(const bf16*)ACT, (const bf16*)WDN, DE / 2, DE / 2, nullptr, -5, nullptr}; pg8::MoeOrder S; S.init(ttab[0], 8, G, c); S.tile_e = ttab + 1; S.tile_l = (const LAS int*)(lds + XTRA_OFF);
        pg8::EpiPlain8 E{YBUF, DM};
        pg8::gemm_phase<pg8::EpiPlain8, pg8::MoeOrder, false, false, true>(lds, g, S, E);
    }
    SEAM(10);

    if (IN(11)) {
        if (MK_N_LAUNCHES != 1) build_tiles2(ECNT, lds);
        const LAS int* tstart = (const LAS int*)(lds + MISC_OFF + 1536);
        const int RPW = NTOK / NGW, row0 = gw * RPW, b = row0 / SEQ;
        float av[32];
#pragma unroll
        for (int j = 0; j < 4; ++j)
#pragma unroll
            for (int i = 0; i < 8; ++i) { const int ch = 512 * j + 8 * lane + i; av[8 * j + i] = g_post_ffn[ch] * MOD[b * NMOD + 5 * DM + ch]; }
        for (int r = 0; r < RPW; ++r) {
            const int tok = row0 + r; const int p0 = tstart[EID[2 * tok]] * 256 + TOKPOS[2 * tok], p1 = tstart[EID[2 * tok + 1]] * 256 + TOKPOS[2 * tok + 1]; const float w0 = WT[2 * tok], w1 = WT[2 * tok + 1];
            const unsigned char* ya = YBUF + (size_t)p0 * DM; const unsigned char* yb = YBUF + (size_t)p1 * DM; float* o1 = out + (size_t)tok * DM;
            const bf16* xr = X1B + (size_t)tok * DM;
            u32x4 xw[4];
#pragma unroll
            for (int j = 0; j < 4; ++j) xw[j] = __builtin_nontemporal_load((const u32x4*)(xr + 512 * j + 8 * lane));
            float yv[32]; float ss = 0.f;
#pragma unroll
            for (int j = 0; j < 4; ++j) { float f[8], f2[8]; unpack8_fp8(__builtin_nontemporal_load((const u32x2*)(ya + 512 * j + 8 * lane)), f); unpack8_fp8(__builtin_nontemporal_load((const u32x2*)(yb + 512 * j + 8 * lane)), f2);
#pragma unroll
                for (int i = 0; i < 8; ++i) { const float v = w0 * f[i] + w1 * f2[i]; yv[8 * j + i] = v; ss += v * v; } }
            const float rs = __builtin_amdgcn_rsqf(wave_sum(ss) * (1.0f / (64.0f * DM)) + EPS) * 0.125f;
#pragma unroll
            for (int j = 0; j < 4; ++j) { float xf[8]; unpack8(xw[j], xf); f32x4 a, bq;
#pragma unroll
                for (int i = 0; i < 4; ++i) { a[i] = xf[i] + av[8 * j + i] * yv[8 * j + i] * rs; bq[i] = xf[4 + i] + av[8 * j + 4 + i] * yv[8 * j + 4 + i] * rs; }
                __builtin_nontemporal_store(a, (f32x4*)(o1 + 512 * j + 8 * lane)); __builtin_nontemporal_store(bq, (f32x4*)(o1 + 512 * j + 8 * lane + 4)); }
        }
    }
    TSTAMP(11);
    if constexpr (kAnyAmp) { const unsigned long long t0_ = __builtin_amdgcn_s_memrealtime(); while (__builtin_amdgcn_s_memrealtime() - t0_ < t_ext) __builtin_amdgcn_s_sleep(32); }
#undef IN
#undef SEAM
#undef TSTAMP
}

extern "C" void kernel_launch(void* const* d_in, const int* in_sizes, int n_in, void* d_out, int out_size, void* d_ws, size_t ws_size, hipStream_t stream) {
    static int grid = 0;
    if (grid == 0) {
        if (n_in != 22 || in_sizes[0] != NTOK * DM || out_size != NTOK * DM || ws_size < WS_END) { fprintf(stderr, "kernel_launch: unexpected shapes (n_in %d, in0 %d, out %d, ws %zu < %zu?)\n", n_in, n_in > 0 ? in_sizes[0] : -1, out_size, ws_size, (size_t)WS_END); grid = -1; return; }
        int dev = 0, cus = 0, per_cu = 0;
        if (hipGetDevice(&dev) != hipSuccess || hipDeviceGetAttribute(&cus, hipDeviceAttributeMultiprocessorCount, dev) != hipSuccess) { grid = -1; return; }
        if (hipFuncSetAttribute((const void*)fwd_kernel, hipFuncAttributeMaxDynamicSharedMemorySize, LDS_BYTES) != hipSuccess) { fprintf(stderr, "kernel_launch: hipFuncSetAttribute failed\n"); grid = -1; return; }
        if (hipOccupancyMaxActiveBlocksPerMultiprocessor(&per_cu, (const void*)fwd_kernel, NWAVES * 64, LDS_BYTES) != hipSuccess || per_cu < 1) { fprintf(stderr, "kernel_launch: occupancy query says %d\n", per_cu); }
        (void)hipGetLastError();
        grid = cus;
        if (grid != 256) fprintf(stderr, "kernel_launch: %d CUs; this kernel is laid out for 256\n", grid);
        if (NTOK % (grid * NWAVES) != 0) { fprintf(stderr, "kernel_launch: grid %d does not divide the token rows\n", grid); grid = -1; return; }
    }
    if (grid < 0) return;
    if (hipMemsetAsync((char*)d_ws + WS_CTL, 0, CTL_ZERO_BYTES, stream) != hipSuccess) return;
    Args a{};
    for (int i = 0; i < 22; ++i) a.in[i] = (const float*)d_in[i];
    a.out = (float*)d_out; a.ws = (unsigned char*)d_ws;
    if (MK_N_LAUNCHES == 1) { a.ph_lo = 0; a.ph_hi = NPHASE; hipLaunchKernelGGL(fwd_kernel, dim3(grid), dim3(NWAVES * 64), LDS_BYTES, stream, a); }
    else { static const int seq[] = {MK_SEQ}; for (int p : seq) { a.ph_lo = p; a.ph_hi = p + 1; hipLaunchKernelGGL(fwd_kernel, dim3(grid), dim3(NWAVES * 64), LDS_BYTES, stream, a); } }
}
```
